# Optimizing an MI355X kernel written in HIP

```python
import jax, jax.numpy as jnp
from jax import lax
import numpy as np

D_MODEL = 2048
BATCH = 4
SEQ = 2048
DEPTH = 1

N_HEADS = 16
QK_NOPE_DIM = 128
QK_ROPE_DIM = 64
QK_HEAD_DIM = QK_NOPE_DIM + QK_ROPE_DIM
V_HEAD_DIM = 128
Q_LORA_RANK = 512
KV_LORA_RANK = 256
ATTN_WIDTH = N_HEADS * V_HEAD_DIM
CONV_WIDTH = D_MODEL // 2
CONV_K = 3
PLE_DIM = 256
Q_BLOCK = 128
ROPE_THETA = 10000.0
EPS = 1e-6

SPLIT_SIZES = (Q_LORA_RANK, KV_LORA_RANK, QK_ROPE_DIM, ATTN_WIDTH,
               CONV_WIDTH, CONV_WIDTH, CONV_WIDTH, CONV_WIDTH, D_MODEL, D_MODEL)
IN_WIDTH = sum(SPLIT_SIZES)

kernel_name = "hybrid_mla_shortconv_gated_block"


def rmsnorm(x, g):
    xf = x.astype(jnp.float32)
    xf = xf * lax.rsqrt(jnp.mean(xf * xf, axis=-1, keepdims=True) + EPS)
    return xf.astype(x.dtype) * g


def rope_tables(positions, dtype):
    inv_freq = 1.0 / (ROPE_THETA ** (jnp.arange(0, QK_ROPE_DIM, 2, dtype=jnp.float32) / QK_ROPE_DIM))
    ang = positions.astype(jnp.float32)[..., None] * inv_freq
    return jnp.cos(ang)[:, :, None, :].astype(dtype), jnp.sin(ang)[:, :, None, :].astype(dtype)


def apply_rope(x, cos, sin):
    x1, x2 = jnp.split(x, 2, axis=-1)
    return jnp.concatenate([x1 * cos - x2 * sin, x2 * cos + x1 * sin], axis=-1)


def split_columns(z):
    idx, acc = [], 0
    for s in SPLIT_SIZES[:-1]:
        acc += s
        idx.append(acc)
    return jnp.split(z, idx, axis=-1)


def blocked_attention(q, k, v):
    b, s, h, d = q.shape
    scale = QK_HEAD_DIM ** -0.5
    qb = q.reshape(b, s // Q_BLOCK, Q_BLOCK, h, d).transpose(1, 0, 2, 3, 4)

    def attend(q_blk):
        sc = jnp.einsum('bqhd,bkhd->bhqk', q_blk, k).astype(jnp.float32) * scale
        pr = jax.nn.softmax(sc, axis=-1).astype(v.dtype)
        return jnp.einsum('bhqk,bkhv->bqhv', pr, v)

    out = lax.map(attend, qb)
    return out.transpose(1, 0, 2, 3, 4).reshape(b, s, h * v.shape[-1])


def centred_conv3(u, w, bias):
    up = jnp.pad(u, ((0, 0), (1, 1), (0, 0)))
    return up[:, :-2] * w[0] + up[:, 1:-1] * w[1] + up[:, 2:] * w[2] + bias


def setup_inputs(seed: int = 0) -> dict:
    key = jax.random.key(seed)
    ks = jax.random.split(key, 20)
    f32 = jnp.float32

    def w(k, shape, fan_in):
        return jax.random.normal(k, shape, f32) * (fan_in ** -0.5)

    def gain(k, shape):
        return 1.0 + 0.02 * jax.random.normal(k, shape, f32)

    return {
        "x": jax.random.normal(ks[0], (BATCH, SEQ, D_MODEL), f32),
        "p": jax.random.normal(ks[1], (DEPTH, BATCH, SEQ, PLE_DIM), f32),
        "positions": jnp.broadcast_to(jnp.arange(SEQ, dtype=jnp.int32), (BATCH, SEQ)),
        "norm_g": gain(ks[2], (DEPTH, D_MODEL)),
        "w_in": w(ks[3], (DEPTH, D_MODEL, IN_WIDTH), D_MODEL),
        "q_lat_g": gain(ks[4], (DEPTH, Q_LORA_RANK)),
        "kv_lat_g": gain(ks[5], (DEPTH, KV_LORA_RANK)),
        "w_uq": w(ks[6], (DEPTH, Q_LORA_RANK, N_HEADS * QK_HEAD_DIM), Q_LORA_RANK),
        "w_ukv": w(ks[7], (DEPTH, KV_LORA_RANK, N_HEADS * (QK_NOPE_DIM + V_HEAD_DIM)), KV_LORA_RANK),
        "q_norm_g": gain(ks[8], (DEPTH, QK_HEAD_DIM)),
        "k_norm_g": gain(ks[9], (DEPTH, QK_HEAD_DIM)),
        "conv_w": w(ks[10], (DEPTH, CONV_K, CONV_WIDTH), CONV_K),
        "conv_b": 0.02 * jax.random.normal(ks[11], (DEPTH, CONV_WIDTH), f32),
        "w_branch_attn": w(ks[12], (DEPTH, ATTN_WIDTH, D_MODEL), ATTN_WIDTH),
        "w_branch_conv": w(ks[13], (DEPTH, CONV_WIDTH, D_MODEL), CONV_WIDTH),
        "w_out": w(ks[14], (DEPTH, D_MODEL, D_MODEL), D_MODEL),
        "ple_norm_g": gain(ks[15], (DEPTH, D_MODEL)),
        "w_ple_gate": w(ks[16], (DEPTH, D_MODEL, D_MODEL), D_MODEL),
        "w_ple_proj": w(ks[17], (DEPTH, PLE_DIM, D_MODEL), PLE_DIM),
    }


def reference(x, p, positions, norm_g, w_in, q_lat_g, kv_lat_g, w_uq, w_ukv,
              q_norm_g, k_norm_g, conv_w, conv_b, w_branch_attn, w_branch_conv,
              w_out, ple_norm_g, w_ple_gate, w_ple_proj):
    b, s, _ = x.shape
    cos, sin = rope_tables(positions, x.dtype)
    for i in range(DEPTH):
        h = rmsnorm(x, norm_g[i])
        z = jnp.einsum('bsd,de->bse', h, w_in[i])
        (q_a, kv_a, k_pe, gate_a, conv_b_gate, conv_c_gate, conv_x,
         gate_c, merge_a, merge_c) = split_columns(z)

        q = jnp.einsum('bsr,re->bse', rmsnorm(q_a, q_lat_g[i]), w_uq[i])
        q = q.reshape(b, s, N_HEADS, QK_HEAD_DIM)
        kv = jnp.einsum('bsr,re->bse', rmsnorm(kv_a, kv_lat_g[i]), w_ukv[i])
        kv = kv.reshape(b, s, N_HEADS, QK_NOPE_DIM + V_HEAD_DIM)
        k_nope, v = kv[..., :QK_NOPE_DIM], kv[..., QK_NOPE_DIM:]
        k_pe_h = jnp.broadcast_to(k_pe[:, :, None, :], (b, s, N_HEADS, QK_ROPE_DIM))
        k = jnp.concatenate([k_nope, k_pe_h], axis=-1)
        q = rmsnorm(q, q_norm_g[i])
        k = rmsnorm(k, k_norm_g[i])
        q = jnp.concatenate([q[..., :QK_NOPE_DIM], apply_rope(q[..., QK_NOPE_DIM:], cos, sin)], axis=-1)
        k = jnp.concatenate([k[..., :QK_NOPE_DIM], apply_rope(k[..., QK_NOPE_DIM:], cos, sin)], axis=-1)
        attn = blocked_attention(q, k, v)
        y_attn = jnp.einsum('bse,ed->bsd', attn * jax.nn.silu(gate_a), w_branch_attn[i])

        cv = conv_b_gate * centred_conv3(conv_c_gate * conv_x, conv_w[i], conv_b[i])
        y_conv = jnp.einsum('bse,ed->bsd', cv * jax.nn.silu(gate_c), w_branch_conv[i])

        merged = jax.nn.sigmoid(merge_a) * y_attn + jax.nn.sigmoid(merge_c) * y_conv
        x = x + jnp.einsum('bsd,de->bse', merged, w_out[i])

        gate = jax.nn.sigmoid(jnp.einsum('bsd,de->bse', rmsnorm(x, ple_norm_g[i]), w_ple_gate[i]))
        x = x + gate * jnp.einsum('bsp,pd->bsd', p[i], w_ple_proj[i])
    return x
```

```cpp
#include <hip/hip_runtime.h>
#include <hip/hip_bf16.h>
#include <cstdio>
#include <cstdint>

#ifndef MK_N_LAUNCHES
#define MK_N_LAUNCHES 1
#endif
#ifndef MK_PHASE_MASK
#define MK_PHASE_MASK 0x1ff
#endif
#ifndef MK_ATT_FP8
#define MK_ATT_FP8 5
#endif
#ifndef MK_BA_FP8
#define MK_BA_FP8 1
#endif
#ifndef MK_MC_FP8
#define MK_MC_FP8 1
#endif
#ifndef MK_CONV_FUSE
#define MK_CONV_FUSE 1
#endif
#ifndef MK_X1_BF16
#define MK_X1_BF16 1
#endif
#ifndef MK_ZS_BF16
#define MK_ZS_BF16 1
#endif
#ifndef MK_GATE_FUSE
#define MK_GATE_FUSE 1
#endif
#ifndef MK_GA_FP8
#define MK_GA_FP8 1
#endif
#ifndef MK_Q_FP8
#define MK_Q_FP8 1
#endif
#ifndef MK_ATT_PERM
#define MK_ATT_PERM 1
#endif
#ifndef MK_EPI_PIPE
#define MK_EPI_PIPE 7
#endif
#ifndef MK_PROBE
#define MK_PROBE 0
#endif
#ifndef MK_REPEAT_MASK
#define MK_REPEAT_MASK 0x000
#endif

__device__ __forceinline__ int lane_id_opaque() { int z = 0; asm volatile("" : "+v"(z)); return (int)__builtin_amdgcn_mbcnt_hi(~0u, __builtin_amdgcn_mbcnt_lo(~0u, (unsigned)z)); }
namespace pg8 {
#define PG8_LAS __attribute__((address_space(3)))
typedef unsigned short bf16_t;
typedef short bf16x8 __attribute__((ext_vector_type(8)));
typedef float f32x4 __attribute__((ext_vector_type(4)));
typedef unsigned u32x4 __attribute__((ext_vector_type(4)));
typedef int i32x4g __attribute__((ext_vector_type(4)));
constexpr int W8_E8M0 = 0x7A7A7A7A;
constexpr int BM = 256, BK = 64, HALF = 128, HTB = HALF * BK * 2, STAGE_BYTES = 8 * HTB, NXCD = 8, WGM = 8;

__host__ __device__ __forceinline__ int lds_byte(int r, int c) { const int st = (r >> 4) * 2 + (c >> 5), rr = r & 15, cc = c & 31, ob = rr * 64 + cc * 2; return st * 1024 + (ob ^ (((ob >> 9) & 1) << 5)); }
__host__ __device__ __forceinline__ void stage_rc(int b, int& R, int& C) { const int st = b / 1024, sb = b % 1024, swz = sb ^ (((sb >> 9) & 1) << 5); R = (st >> 1) * 16 + swz / 64; C = (st & 1) * 32 + (swz % 64) / 2; }
__host__ __device__ __forceinline__ int perm32(int rho) { const int n = rho >> 4, i = rho & 15; return 8 * (i >> 2) + 4 * n + (i & 3); }

struct Unit { int pm, pn; };
struct Gemm { const bf16_t* A; const bf16_t* Bt; int M, N, K; };

struct StaticOrder {
    int nM, nN, nwg, G, c;
    __host__ __device__ void init(int M, int N, int G_, int c_) { nM = M / BM; nN = N / BM; nwg = nM * nN; G = G_; c = c_; }
    __host__ __device__ bool next(int i, Unit& u) const {
        const long L = (long)i * G + c; if (L >= nwg) return false;
        int wgid = (int)L; { const int q = nwg / NXCD, r = nwg % NXCD, xcd = wgid % NXCD, off = wgid / NXCD; wgid = (xcd < r ? xcd * (q + 1) : r * (q + 1) + (xcd - r) * q) + off; }
        const int nig = WGM * nN, gid = wgid / nig, fm = gid * WGM, gsz = (nM - fm) < WGM ? (nM - fm) : WGM;
        u.pm = fm + ((wgid % nig) % gsz); u.pn = (wgid % nig) / gsz; return true;
    }
    __device__ __forceinline__ void a_ready(const Unit&) const {}
    __device__ __forceinline__ void done(const Unit&) const {}
};

__device__ __forceinline__ unsigned cvt_pk_bf16(float lo, float hi) { unsigned r; asm volatile("v_cvt_pk_bf16_f32 %0, %1, %2" : "=v"(r) : "v"(lo), "v"(hi)); return r; }

template <class Epi, class Sched, bool ALIGN_EPI = false, bool SP2 = false, int HOOK_T = -1, int FP8_T0 = (1 << 30), int A8SC = 0x7F7F7F7F>
__device__ __forceinline__ void gemm_phase(PG8_LAS unsigned char* lds, const Gemm g, const Sched& S, const Epi& E, const int wid) {
    const int lane = lane_id_opaque(), tid = wid * 64 + lane,
              wr = wid >> 2, wc = wid & 3, fr = lane & 15, fq = lane >> 4;
    const int K = g.K, nt = K / BK;
    unsigned voffA[2], voffB[2];
#pragma unroll
    for (int i = 0; i < 2; ++i) { int R, C; stage_rc(tid * 16 + i * 8192, R, C); const int Rb = Epi::PERM ? ((R & ~31) + perm32(R & 31)) : R;
        voffA[i] = (unsigned)(R * K + C) * 2u; voffB[i] = (unsigned)(Rb * K + C) * 2u; }
    const size_t kstep = (size_t)(BK * 2);
    const size_t hstep = (size_t)HALF * K * 2;
    const size_t tstep = 2 * hstep;
    const unsigned ldsw = (unsigned)wid * 1024u;
    const int aoff = lds_byte(wr * 64 + fr, fq * 8), boff = lds_byte(wc * 32 + fr, fq * 8);
#define PG8_SA(b, h) (((b) * 2 + (h)) * HTB)
#define PG8_SB(b, h) ((4 + (b) * 2 + (h)) * HTB)
#define PG8_STAGE(bufoff, gbase, voff) do { _Pragma("unroll") for (int _i = 0; _i < 2; ++_i) \
        __builtin_amdgcn_global_load_lds((const unsigned*)((const char*)(gbase) + (voff)[_i]), (PG8_LAS unsigned*)(lds + (bufoff) + ldsw + _i * 8192), 16, 0, 0); } while (0)
#define PG8_LDA(dst, b, h) do { _Pragma("unroll") for (int m = 0; m < 4; ++m) _Pragma("unroll") for (int k = 0; k < 2; ++k) dst[m][k] = *(const PG8_LAS bf16x8*)(lds + PG8_SA(b, h) + aoff + m * 2048 + k * 1024); } while (0)
#define PG8_LDB(dst, b, h) do { _Pragma("unroll") for (int n = 0; n < 2; ++n) _Pragma("unroll") for (int k = 0; k < 2; ++k) dst[n][k] = *(const PG8_LAS bf16x8*)(lds + PG8_SB(b, h) + boff + n * 2048 + k * 1024); } while (0)
#define PG8_MMA(ai, bj, At, Bt) do { __builtin_amdgcn_s_setprio(1); _Pragma("unroll") for (int m = 0; m < 4; ++m) _Pragma("unroll") for (int n = 0; n < 2; ++n) _Pragma("unroll") for (int k = 0; k < 2; ++k) \
        acc[ai][bj][m][n] = __builtin_amdgcn_mfma_f32_16x16x32_bf16(Bt[n][k], At[m][k], acc[ai][bj][m][n], 0, 0, 0); __builtin_amdgcn_s_setprio(0); } while (0)
#define PG8_CAT8(x0, x1) __builtin_shufflevector(__builtin_bit_cast(i32x4g, x0), __builtin_bit_cast(i32x4g, x1), 0, 1, 2, 3, 4, 5, 6, 7)
#define PG8_MMA8(ai, bj, At, Bt) do { __builtin_amdgcn_s_setprio(1); _Pragma("unroll") for (int m = 0; m < 4; ++m) _Pragma("unroll") for (int n = 0; n < 2; ++n) \
        asm volatile("v_mfma_scale_f32_16x16x128_f8f6f4 %0, %1, %2, %0, %3, %4 op_sel_hi:[0,0,0]" : "+v"(acc[ai][bj][m][n]) : "v"(PG8_CAT8(Bt[n][0], Bt[n][1])), "v"(PG8_CAT8(At[m][0], At[m][1])), "v"(w8sc), "v"(one8sc)); \
        __builtin_amdgcn_s_setprio(0); } while (0)
#define PG8_MMA16A(ai, bj, At, Bt) do { __builtin_amdgcn_s_setprio(1); _Pragma("unroll") for (int m = 0; m < 4; ++m) _Pragma("unroll") for (int n = 0; n < 2; ++n) _Pragma("unroll") for (int k = 0; k < 2; ++k) \
        asm volatile("v_mfma_f32_16x16x32_bf16 %0, %1, %2, %0" : "+v"(acc[ai][bj][m][n]) : "v"(Bt[n][k]), "v"(At[m][k])); __builtin_amdgcn_s_setprio(0); } while (0)
#define PG8_WAIT_V(n) asm volatile("s_waitcnt vmcnt(" #n ")" ::: "memory")
#define PG8_WAIT_L(n) asm volatile("s_waitcnt lgkmcnt(" #n ")" ::: "memory")
#define PG8_BAR __builtin_amdgcn_s_barrier()
#define PG8_SCHED __builtin_amdgcn_sched_barrier(0)
    Unit cur, nxt; int ui = 0;
    if (!S.next(0, cur)) return;
    f32x4 acc[2][2][4][2];
#pragma unroll
    for (int a = 0; a < 2; ++a)
#pragma unroll
        for (int b = 0; b < 2; ++b)
#pragma unroll
            for (int m = 0; m < 4; ++m)
#pragma unroll
                for (int n = 0; n < 2; ++n) acc[a][b][m][n] = (f32x4){0.f, 0.f, 0.f, 0.f};
    bf16x8 At[4][2], B0[2][2], B1[2][2];
    int w8sc = W8_E8M0, one8sc = A8SC; if (FP8_T0 < (1 << 30)) asm volatile("" : "+v"(w8sc), "+v"(one8sc));
    const char* cA = (const char*)g.A + (size_t)cur.pm * tstep; const char* cB = (const char*)g.Bt + (size_t)cur.pn * tstep;
    S.a_ready(cur);
    if constexpr (SP2) {
        PG8_STAGE(PG8_SB(0, 0), cB, voffB); PG8_STAGE(PG8_SB(0, 1), cB + hstep, voffB); PG8_STAGE(PG8_SA(0, 0), cA, voffA); PG8_STAGE(PG8_SA(0, 1), cA + hstep, voffA);
        if (wr == 1) PG8_BAR;
        PG8_WAIT_V(2); PG8_BAR;
        PG8_STAGE(PG8_SB(1, 0), cB + kstep, voffB); PG8_STAGE(PG8_SA(1, 0), cA + kstep, voffA); PG8_STAGE(PG8_SB(1, 1), cB + hstep + kstep, voffB);
        PG8_WAIT_V(6); PG8_BAR;
    } else {
        PG8_STAGE(PG8_SB(0, 0), cB, voffB); PG8_STAGE(PG8_SA(0, 0), cA, voffA); PG8_STAGE(PG8_SB(0, 1), cB + hstep, voffB); PG8_STAGE(PG8_SA(0, 1), cA + hstep, voffA);
        if (wr == 1) PG8_BAR;
        PG8_WAIT_V(4); PG8_BAR;
        PG8_STAGE(PG8_SB(1, 0), cB + kstep, voffB); PG8_STAGE(PG8_SA(1, 0), cA + kstep, voffA); PG8_STAGE(PG8_SB(1, 1), cB + hstep + kstep, voffB);
        PG8_WAIT_V(6); PG8_BAR;
    }
    for (;;) {
        const bool has_next = S.next(ui + 1, nxt);
        const char* nA = has_next ? (const char*)g.A + (size_t)nxt.pm * tstep : cA; const char* nB = has_next ? (const char*)g.Bt + (size_t)nxt.pn * tstep : cB;
#define PG8_TPRE const bool last = (t == nt - 2); const char* a1 = cA + (size_t)(t + 1) * kstep; \
            const char* a2 = last ? nA : cA + (size_t)(t + 2) * kstep; const char* b2 = last ? nB : cB + (size_t)(t + 2) * kstep; const char* a3 = a2 + kstep; const char* b3 = b2 + kstep; \
            if (last && has_next) S.a_ready(nxt);
#define PG8_PAIR_SP2(MM) \
            PG8_LDB(B0, 0, 0); PG8_LDB(B1, 0, 1); PG8_SCHED; PG8_LDA(At, 0, 0); PG8_STAGE(PG8_SA(1, 1), a1 + hstep, voffA); \
            PG8_WAIT_V(8); PG8_WAIT_L(0); PG8_BAR; MM(0, 0, At, B0); MM(0, 1, At, B1); PG8_BAR; PG8_SCHED; \
            PG8_LDA(At, 0, 1); PG8_STAGE(PG8_SB(0, 0), b2, voffB); PG8_STAGE(PG8_SB(0, 1), b2 + hstep, voffB); PG8_STAGE(PG8_SA(0, 0), a2, voffA); \
            PG8_WAIT_V(8); PG8_WAIT_L(0); PG8_BAR; MM(1, 0, At, B0); MM(1, 1, At, B1); PG8_BAR; PG8_SCHED; \
            PG8_LDB(B0, 1, 0); PG8_LDB(B1, 1, 1); PG8_SCHED; PG8_LDA(At, 1, 0); PG8_STAGE(PG8_SA(0, 1), a2 + hstep, voffA); \
            PG8_WAIT_V(8); PG8_WAIT_L(0); PG8_BAR; MM(0, 0, At, B0); MM(0, 1, At, B1); PG8_BAR; PG8_SCHED; \
            PG8_LDA(At, 1, 1); PG8_STAGE(PG8_SB(1, 0), b3, voffB); PG8_STAGE(PG8_SB(1, 1), b3 + hstep, voffB); PG8_STAGE(PG8_SA(1, 0), a3, voffA); \
            PG8_WAIT_V(8); PG8_WAIT_L(0); PG8_BAR; MM(1, 0, At, B0); MM(1, 1, At, B1); PG8_BAR; PG8_SCHED;
#define PG8_HOOK do { if (FP8_T0 < (1 << 30)) asm volatile("s_nop 15\n\ts_nop 3" ::: "memory"); const int l2_ = lane_id_opaque(); E.mid(acc, cur, wr, wc, l2_ & 15, l2_ >> 4); } while (0)
        if constexpr (SP2 && FP8_T0 > 0 && FP8_T0 < (1 << 30)) {
            static_assert(HOOK_T < 0 || HOOK_T == FP8_T0, "the mid-K hook of a mixed GEMM sits at the bf16 / e4m3 seam");
            for (int t = 0; t < FP8_T0; t += 2) { PG8_TPRE PG8_PAIR_SP2(PG8_MMA16A) }
            if constexpr (HOOK_T >= 0) PG8_HOOK;
            for (int t = FP8_T0; t < nt; t += 2) { PG8_TPRE PG8_PAIR_SP2(PG8_MMA8) }
        } else {
        for (int t = 0; t < nt; t += 2) {
            PG8_TPRE
            if constexpr (HOOK_T >= 0) { if (t == HOOK_T) PG8_HOOK; }
            if constexpr (SP2) {
            if constexpr (FP8_T0 <= 0) { PG8_PAIR_SP2(PG8_MMA8) } else { PG8_PAIR_SP2(PG8_MMA) }
            } else {
            PG8_LDB(B0, 0, 0); PG8_SCHED; PG8_LDA(At, 0, 0); PG8_STAGE(PG8_SA(1, 1), a1 + hstep, voffA);
            PG8_WAIT_L(8); PG8_BAR; PG8_WAIT_L(0); PG8_MMA(0, 0, At, B0); PG8_BAR; PG8_SCHED;
            PG8_LDB(B1, 0, 1); PG8_STAGE(PG8_SB(0, 0), b2, voffB);
            PG8_BAR; PG8_WAIT_L(0); PG8_MMA(0, 1, At, B1); PG8_BAR;
            PG8_LDA(At, 0, 1); PG8_STAGE(PG8_SA(0, 0), a2, voffA);
            PG8_BAR; PG8_WAIT_L(0); PG8_MMA(1, 0, At, B0); PG8_BAR; PG8_SCHED;
            PG8_STAGE(PG8_SB(0, 1), b2 + hstep, voffB);
            PG8_WAIT_V(6); PG8_BAR; PG8_MMA(1, 1, At, B1); PG8_BAR;
            PG8_LDB(B0, 1, 0); PG8_SCHED; PG8_LDA(At, 1, 0); PG8_STAGE(PG8_SA(0, 1), a2 + hstep, voffA);
            PG8_WAIT_L(8); PG8_BAR; PG8_WAIT_L(0); PG8_MMA(0, 0, At, B0); PG8_BAR; PG8_SCHED;
            PG8_LDB(B1, 1, 1); PG8_STAGE(PG8_SB(1, 0), b3, voffB);
            PG8_BAR; PG8_WAIT_L(0); PG8_MMA(0, 1, At, B1); PG8_BAR;
            PG8_LDA(At, 1, 1); PG8_STAGE(PG8_SA(1, 0), a3, voffA);
            PG8_BAR; PG8_WAIT_L(0); PG8_MMA(1, 0, At, B0); PG8_BAR; PG8_SCHED;
            PG8_STAGE(PG8_SB(1, 1), b3 + hstep, voffB);
            PG8_WAIT_V(6); PG8_BAR; PG8_MMA(1, 1, At, B1); PG8_BAR;
            }
        }
        }
#undef PG8_TPRE
#undef PG8_PAIR_SP2
#undef PG8_HOOK
        if constexpr (ALIGN_EPI) { if (wr == 0) PG8_BAR; }
        if (FP8_T0 < (1 << 30)) asm volatile("s_nop 15\n\ts_nop 3" ::: "memory");
        { const int l2_ = lane_id_opaque(); E(acc, cur, wr, wc, l2_ & 15, l2_ >> 4); }
        S.done(cur);
        if (!has_next) break;
#pragma unroll
        for (int a = 0; a < 2; ++a)
#pragma unroll
            for (int b = 0; b < 2; ++b)
#pragma unroll
                for (int m = 0; m < 4; ++m)
#pragma unroll
                    for (int n = 0; n < 2; ++n) acc[a][b][m][n] = (f32x4){0.f, 0.f, 0.f, 0.f};
        cur = nxt; cA = nA; cB = nB; ++ui;
        if constexpr (ALIGN_EPI) { if (wr == 1) PG8_BAR; }
    }
    PG8_WAIT_V(0);
    if constexpr (!ALIGN_EPI) { if (wr == 0) PG8_BAR; }
    PG8_BAR;
#undef PG8_SA
#undef PG8_SB
#undef PG8_STAGE
#undef PG8_LDA
#undef PG8_LDB
#undef PG8_MMA
#undef PG8_MMA8
#undef PG8_MMA16A
#undef PG8_CAT8
#undef PG8_WAIT_V
#undef PG8_WAIT_L
#undef PG8_BAR
#undef PG8_SCHED
}
}

constexpr int NWAVES = 8;
constexpr int BATCH = 4, SEQ = 2048, DM = 2048, MTOK = BATCH * SEQ;
constexpr int NH = 16, DNOPE = 128, DROPE = 64, DQK = 192, DV = 128;
constexpr int QR = 512, KVR = 256, PLE = 256, CW = 1024, INW = 11072;
constexpr int ZN = 11264;
constexpr float EPS = 1e-6f;
constexpr float LOG2E = 1.4426950408889634f;

constexpr size_t MiB = 1u << 20;
constexpr size_t WS_CTL = 0, CTL_ZERO_BYTES = 16384;
constexpr size_t WS_COS = 1 * MiB, WS_SIN = 2 * MiB, WS_RK = 3 * MiB, WS_SSQKPE = 5 * MiB, WS_SSQ1P = 6 * MiB;
constexpr size_t WS_WIN = 8 * MiB, WS_WUQ = 52 * MiB, WS_WUKV = 55 * MiB, WS_WCAT = 57 * MiB  , WS_WOUT = 69 * MiB, WS_WPG = 77 * MiB, WS_WPP = 85 * MiB;
constexpr size_t WS_GA = 86 * MiB, WS_MAMC = 118 * MiB;
constexpr size_t WS_CONV4 = 182 * MiB, WS_ZS = 246 * MiB, WS_H = 278 * MiB;
constexpr size_t WS_Q = 182 * MiB, WS_KF = 230 * MiB, WS_VT = 278 * MiB;
constexpr size_t WS_KF8_LO = (MK_ATT_FP8 == 2) ? 40 * MiB : WS_KF, WS_KF8_HI = (MK_ATT_FP8 == 2) ? 322 * MiB : WS_KF + 12 * MiB;
constexpr int CW_CHK = 3600;
constexpr size_t WS_MERGED = 182 * MiB, WS_X1G = 214 * MiB, WS_PPROJ = 8 * MiB  , WS_X1F = 118 * MiB  ;
constexpr size_t WS_WIN8 = 32 * MiB  , WS_H8 = 310 * MiB  ;
constexpr float W8_SCALE = 32.0f;
constexpr size_t WS_QLAT = 310 * MiB, WS_KVLAT = 318 * MiB, WS_CVG = 322 * MiB, WS_PB = 338 * MiB, WS_END = 342 * MiB;
constexpr size_t OUT_ACAT = 0;
constexpr int ACAT_LD = MK_BA_FP8 ? CW + DM / 2 : CW + DM;
constexpr float ATT8_SCALE = 16.0f;
static_assert(!MK_BA_FP8 || MK_ATT_FP8 >= 4, "MK_BA_FP8 needs the attention variant that writes e4m3 ATTG");

constexpr int CW_TMO = 0, CW_BAR = 0;

constexpr int RING_OFF = 0, RING_BYTES = 131072;
constexpr int LDS_BYTES = 163840;
constexpr int LDSCTL_OFF = LDS_BYTES - 512, MISC_OFF = LDSCTL_OFF + 320;
constexpr int EPI_RED_OFF = RING_BYTES;
static_assert(128 * 257 * 4 <= LDSCTL_OFF, "prologue transpose tile");

#define GAS __attribute__((address_space(1)))
#define LAS __attribute__((address_space(3)))
typedef unsigned short bf16;
typedef unsigned v4u __attribute__((ext_vector_type(4)));
typedef unsigned v2u __attribute__((ext_vector_type(2)));
typedef float f32x4 __attribute__((ext_vector_type(4)));
typedef float f32x16 __attribute__((ext_vector_type(16)));
typedef short bf16x8 __attribute__((ext_vector_type(8)));
typedef short s16x4 __attribute__((ext_vector_type(4)));
typedef GAS unsigned gu32;
#define RLX_AGENT __ATOMIC_RELAXED, __HIP_MEMORY_SCOPE_AGENT
#define LDS_WAIT() asm volatile("s_waitcnt lgkmcnt(0)" ::: "memory")
#define VM_WAIT() asm volatile("s_waitcnt vmcnt(0)" ::: "memory")
__device__ __forceinline__ unsigned f2bf(float f) { unsigned u = __builtin_bit_cast(unsigned, f); return (u + 0x7fffu + ((u >> 16) & 1u)) >> 16; }
__device__ __forceinline__ unsigned pk2(float lo, float hi) { return f2bf(lo) | (f2bf(hi) << 16); }
__device__ __forceinline__ unsigned pack4_fp8(float a, float b, float c, float d) { int w = __builtin_amdgcn_cvt_pk_fp8_f32(a, b, 0, false); w = __builtin_amdgcn_cvt_pk_fp8_f32(c, d, w, true); return (unsigned)w; }
__device__ __forceinline__ float bflo(unsigned w) { return __builtin_bit_cast(float, w << 16); }
__device__ __forceinline__ float bfhi(unsigned w) { return __builtin_bit_cast(float, w & 0xffff0000u); }
__device__ __forceinline__ float sigmoidf_(float x) { return __builtin_amdgcn_rcpf(1.0f + __builtin_amdgcn_exp2f(-x * LOG2E)); }
__device__ __forceinline__ float siluf_(float x) { return x * sigmoidf_(x); }

#define XB_TMO      128
#define XB_XCNT(j)  (256  + 64 * (j))
#define XB_XSUB(j)  (1280 + 64 * (j))
#define XB_XGEN(j)  (2304 + 64 * (j))
#define XB_TOP      3328
#define XB_TOPGEN   3392
#define XCD_BAR_WORDS 3456
#define XB_SPIN_CAP (1u << 18)
__device__ __forceinline__ unsigned xb_ld(unsigned* p)              { return __hip_atomic_load(p, __ATOMIC_RELAXED, __HIP_MEMORY_SCOPE_AGENT); }
__device__ __forceinline__ unsigned xb_add(unsigned* p, unsigned v) { return __hip_atomic_fetch_add(p, v, __ATOMIC_RELAXED, __HIP_MEMORY_SCOPE_AGENT); }
__device__ __forceinline__ unsigned xb_xcc_id() { return (unsigned)__builtin_amdgcn_s_getreg((3 << 11) | 20) & 0xFu; }
#define XB_SPIN(cond, bar) do { unsigned _sp = 0; while (cond) { __builtin_amdgcn_s_sleep(1); \
    if ((++_sp & 255u) == 0u) { if (xb_ld(&(bar)[XB_TMO])) break; if (_sp > XB_SPIN_CAP) { atomicAdd(&(bar)[XB_TMO], 1u); break; } } } } while (0)
struct XcdBarrier { unsigned* bar; unsigned x; volatile LAS unsigned* st; };
__device__ __forceinline__ XcdBarrier xcd_barrier_post(unsigned* bar, volatile LAS unsigned* st) {
    XcdBarrier b; b.bar = bar; b.x = xb_xcc_id(); b.st = st;
    if (threadIdx.x == 0) (void)xb_add(&bar[XB_XCNT(b.x)], 1u);
    return b;
}
__device__ __forceinline__ void xcd_barrier_complete(unsigned* bar, unsigned x, unsigned& nloc, unsigned& nx) {
    const unsigned G = gridDim.x * gridDim.y * gridDim.z;
    unsigned sum, cnt, mine, sp = 0u;
    for (;;) {
        sum = 0u; cnt = 0u; mine = 0u;
#pragma unroll
        for (unsigned j = 0; j < 16; ++j) { const unsigned c = xb_ld(&bar[XB_XCNT(j)]); sum += c; cnt += (c > 0u) ? 1u : 0u; mine = (j == x) ? c : mine; }
        if (sum == G) break;
        __builtin_amdgcn_s_sleep(1);
        if ((++sp & 255u) == 0u) { if (xb_ld(&bar[XB_TMO])) break; if (sp > XB_SPIN_CAP) { atomicAdd(&bar[XB_TMO], 1u); break; } }
    }
    nloc = mine > 0u ? mine : 1u; nx = cnt > 0u ? cnt : 1u;
}
__device__ __forceinline__ void xcd_barrier(const XcdBarrier& b) {
    asm volatile("s_waitcnt vmcnt(0)" ::: "memory");
    __syncthreads();
    if (threadIdx.x == 0) {
        unsigned* bar = b.bar;
        __builtin_amdgcn_s_waitcnt(0);
        unsigned nloc = b.st[0], nx = b.st[1];
        if (nloc == 0u) { xcd_barrier_complete(bar, b.x, nloc, nx); b.st[0] = nloc; b.st[1] = nx; }
        const unsigned old = xb_add(&bar[XB_XSUB(b.x)], 1u);
        const unsigned gen = old / nloc;
        if (old + 1u == (gen + 1u) * nloc) {
            __builtin_amdgcn_fence(__ATOMIC_RELEASE, "agent");
            asm volatile("s_waitcnt vmcnt(0)" ::: "memory");
            const unsigned og = xb_add(&bar[XB_TOP], 1u);
            const unsigned tg = og / nx;
            if (og + 1u == (tg + 1u) * nx) xb_add(&bar[XB_TOPGEN], 1u);
            else XB_SPIN(xb_ld(&bar[XB_TOPGEN]) == tg, bar);
            __builtin_amdgcn_fence(__ATOMIC_ACQUIRE, "agent");
            xb_add(&bar[XB_XGEN(b.x)], 1u);
            asm volatile("s_waitcnt vmcnt(0)" ::: "memory");
        } else {
            XB_SPIN(xb_ld(&bar[XB_XGEN(b.x)]) == gen, bar);
            __builtin_amdgcn_fence(__ATOMIC_ACQUIRE, "agent");
            asm volatile("s_waitcnt vmcnt(0)" ::: "memory");
        }
    }
    __syncthreads();
}

struct Args {
    const float* x; const float* p; const int* positions; const float* norm_g; const float* w_in; const float* q_lat_g; const float* kv_lat_g;
    const float* w_uq; const float* w_ukv; const float* q_norm_g; const float* k_norm_g; const float* conv_w; const float* conv_b;
    const float* w_ba; const float* w_bc; const float* w_out; const float* ple_norm_g; const float* w_pg; const float* w_pp;
    float* out; unsigned char* ws; int ph_lo, ph_hi;
};

struct Frame {
    LAS unsigned char* lds; int wave, vcu, G;
};

__device__ __forceinline__ float wave_sum(float v) {
#pragma unroll
    for (int o = 1; o < 64; o <<= 1) v += __shfl_xor(v, o);
    return v;
}

struct P0Item { const float* W; const float* kscale; bf16* WT; int K, N, dst_row0, src_col0, k0, ncols; int f8; int split; int perm; };
constexpr int P0_LD = 257;
__device__ __forceinline__ void p0_item_load(const P0Item& d, f32x4 (&v)[16], int wave, int lane) {
    if (4 * lane < d.ncols) { const float* src = d.W + (size_t)(d.k0 + 16 * wave) * d.N + d.src_col0 + 4 * lane;
#pragma unroll
        for (int i = 0; i < 16; ++i) v[i] = *(const f32x4*)(src + (size_t)i * d.N); }
}
__device__ __forceinline__ void p0_item_store(const P0Item& d, f32x4 (&v)[16], LAS float* tile, int wave, int lane) {
    if (4 * lane < d.ncols) {
#pragma unroll
        for (int i = 0; i < 16; ++i) { const float sc = d.kscale ? d.kscale[d.k0 + 16 * wave + i] : 1.0f; LAS float* t = tile + (16 * wave + i) * P0_LD + 4 * lane;
            t[0] = v[i][0] * sc; t[1] = v[i][1] * sc; t[2] = v[i][2] * sc; t[3] = v[i][3] * sc; } }
    __syncthreads();
    const int c = lane & 15;
#pragma unroll
    for (int jj = 0; jj < 8; ++jj) { const int n = 32 * wave + 4 * jj + (lane >> 4);
        if (n < d.ncols) { const LAS float* t = tile + (8 * c) * P0_LD + n;
            if (d.f8 && (d.perm & 2)) { const LAS float* tp = tile + (2 * c) * P0_LD + n; v2u o;
                o.x = pack4_fp8(tp[0 * P0_LD] * W8_SCALE, tp[32 * P0_LD] * W8_SCALE, tp[64 * P0_LD] * W8_SCALE, tp[96 * P0_LD] * W8_SCALE);
                o.y = pack4_fp8(tp[1 * P0_LD] * W8_SCALE, tp[33 * P0_LD] * W8_SCALE, tp[65 * P0_LD] * W8_SCALE, tp[97 * P0_LD] * W8_SCALE);
                *(GAS v2u*)((unsigned char*)d.WT + (size_t)(d.dst_row0 + n) * d.K + d.k0 + 8 * c) = o; }
            else if (d.f8) { v2u o; o.x = pack4_fp8(t[0 * P0_LD] * W8_SCALE, t[1 * P0_LD] * W8_SCALE, t[2 * P0_LD] * W8_SCALE, t[3 * P0_LD] * W8_SCALE);
                o.y = pack4_fp8(t[4 * P0_LD] * W8_SCALE, t[5 * P0_LD] * W8_SCALE, t[6 * P0_LD] * W8_SCALE, t[7 * P0_LD] * W8_SCALE);
                *(GAS v2u*)((unsigned char*)d.WT + (size_t)(d.dst_row0 + ((d.perm & 1) ? ((n & 128) | (4 * (n & 31) + ((n >> 5) & 3))) : n + (n >= 128 ? d.split : 0))) * d.K + d.k0 + 8 * c) = o; }
            else { v4u o; o.x = pk2(t[0 * P0_LD], t[1 * P0_LD]); o.y = pk2(t[2 * P0_LD], t[3 * P0_LD]); o.z = pk2(t[4 * P0_LD], t[5 * P0_LD]); o.w = pk2(t[6 * P0_LD], t[7 * P0_LD]);
                *(GAS v4u*)(d.WT + (size_t)(d.dst_row0 + ((d.perm & 1) ? ((n & 128) | (4 * (n & 31) + ((n >> 5) & 3))) : n + (n >= 128 ? d.split : 0))) * d.K + d.k0 + 8 * c) = o; } } }
    __syncthreads();
}

__device__ __forceinline__ float inv_freq_f32(int i) {
    constexpr unsigned T[32] = {0x3f800000, 0x3f3ff911, 0x3f0ff59a, 0x3ed7e89b, 0x3ea1e89b, 0x3e72d425, 0x3e361887, 0x3e088d77, 0x3dcccccd, 0x3d99940d, 0x3d6655c2, 0x3d2cba15, 0x3d0186e3, 0x3cc2434f, 0x3c91ad39, 0x3c5a7bf2,
        0x3c23d70a, 0x3bf5b9b0, 0x3bb8449c, 0x3b8a2e77, 0x3b4f3e38, 0x3b1b690d, 0x3ae91528, 0x3aaec98e, 0x3a83126f, 0x3a44948c, 0x3a136a16, 0x39dd1727, 0x39a5cb60, 0x3978a815, 0x393a7753, 0x390bd472};
    return __builtin_bit_cast(float, T[i]);
}
__device__ __forceinline__ void sincos_acc(float ang, float& s, float& c) {
    const double a = (double)ang;
    const double kd = __builtin_rint(a * 0.63661977236758134308);
    double r = __builtin_fma(-kd, 1.57079632679489655800e+00, a);
    r = __builtin_fma(-kd, 6.12323399573676603587e-17, r);
    const int q = (int)((long long)kd & 3ll);
    const double r2 = r * r;
    double sp = 1.0 / 6227020800.0; sp = sp * r2 - 1.0 / 39916800.0; sp = sp * r2 + 1.0 / 362880.0; sp = sp * r2 - 1.0 / 5040.0; sp = sp * r2 + 1.0 / 120.0; sp = sp * r2 - 1.0 / 6.0; sp = sp * r2 + 1.0; sp *= r;
    double cp = -1.0 / 87178291200.0; cp = cp * r2 + 1.0 / 479001600.0; cp = cp * r2 - 1.0 / 3628800.0; cp = cp * r2 + 1.0 / 40320.0; cp = cp * r2 - 1.0 / 720.0; cp = cp * r2 + 1.0 / 24.0; cp = cp * r2 - 0.5; cp = cp * r2 + 1.0;
    const double ss = (q & 1) ? cp : sp, cc = (q & 1) ? sp : cp;
    s = (float)((q & 2) ? -ss : ss); c = (float)(((q + 1) & 2) ? -cc : cc);
}

constexpr int P1_NT16 = MK_MC_FP8 ? 16 : 24, P1_NT8 = MK_MC_FP8 ? 28 : 20;
constexpr int P0_NB_IN = (INW + 255) / 256;
constexpr int P0_I_IN = (DM / 128) * P0_NB_IN, P0_I_UQ = (QR / 128) * (NH * DQK / 256), P0_I_UKV = (KVR / 128) * (NH * 256 / 256), P0_I_BA = (DM / 128) * (DM / 256), P0_I_BC = (CW / 128) * (DM / 256),
              P0_I_OUT = (DM / 128) * (DM / 256), P0_I_PG = P0_I_OUT, P0_I_PP = (PLE / 128) * (DM / 256);
constexpr int P0_NITEMS = P0_I_IN + P0_I_UQ + P0_I_UKV + P0_I_BA + P0_I_BC + P0_I_OUT + P0_I_PG + P0_I_PP;
constexpr int P0_EARLY = P0_I_IN + P0_I_UQ + P0_I_UKV;
constexpr int P0_IN_P3 = 144;
__device__ __forceinline__ P0Item p0_decode(const Args& A, int it) {
    unsigned char* ws = A.ws; P0Item d; int r = it;
    if (r < P0_I_IN) { const int kb = r / P0_NB_IN, nb = r % P0_NB_IN;
        d = P0Item{A.w_in, nullptr, (bf16*)(ws + WS_WIN8), DM, INW, 0, 0, 128 * kb, 256, 1};
        if (nb < 3) { d.src_col0 = 256 * nb; d.dst_row0 = 256 * nb; }
        else if (nb == 3) { d.src_col0 = 768; d.dst_row0 = 768; d.ncols = 64; }
        else { const int q = nb - 4; d.src_col0 = 832 + 256 * q;
            if (q < 8) { d.dst_row0 = 1024 + 256 * q; if (MK_ATT_PERM && MK_GA_FP8 && MK_ATT_FP8 == 5) d.perm = 1; }
            else if (q < 24) { d.WT = (bf16*)(ws + WS_WIN); d.f8 = 0;
                if (MK_CONV_FUSE) { const int kind = (q - 8) >> 2, sb = (q - 8) & 3;
                    const int base = (kind == 1 || kind == 2) ? 0 : 8, half = (kind == 2 || kind == 3) ? 1 : 0; d.dst_row0 = (base + 2 * sb) * 256 + half * 128; d.split = 128; }
                else d.dst_row0 = 256 * (q - 8); }
            else if (MK_GATE_FUSE && MK_MC_FP8) { const int kind = (q - 24) >> 3, sb = (q - 24) & 7; d.dst_row0 = (12 + 2 * sb) * 256 + kind * 128; d.split = 128; }
            else if (q < 32) d.dst_row0 = 3072 + 256 * (q - 24);
            else if (MK_MC_FP8) d.dst_row0 = 5120 + 256 * (q - 32);
            else { d.WT = (bf16*)(ws + WS_WIN); d.f8 = 0; d.dst_row0 = 4096 + 256 * (q - 32); } }
        return d; } r -= P0_I_IN;
    if (r < P0_I_UQ) { const int nblk = NH * DQK / 256, kb = r / nblk, nb = r % nblk; d = P0Item{A.w_uq, A.q_lat_g, (bf16*)(ws + WS_WUQ), QR, NH * DQK, 256 * nb, 256 * nb, 128 * kb, 256, 1}; return d; } r -= P0_I_UQ;
    if (r < P0_I_UKV) { const int nblk = NH * 256 / 256, kb = r / nblk, nb = r % nblk; d = P0Item{A.w_ukv, A.kv_lat_g, (bf16*)(ws + WS_WUKV), KVR, NH * 256, 256 * nb, 256 * nb, 128 * kb, 256, 0}; return d; } r -= P0_I_UKV;
    const int nblk = DM / 256;
    if (r < P0_I_BA) { const int kb = r / nblk, nb = r % nblk; d = MK_BA_FP8 ? P0Item{A.w_ba, nullptr, (bf16*)(ws + WS_WCAT) + CW, 2 * ACAT_LD, DM, 256 * nb, 256 * nb, 128 * kb, 256, 1, 0, (MK_ATT_PERM && MK_GA_FP8 && MK_ATT_FP8 == 5) ? 2 : 0}
                                            : P0Item{A.w_ba, nullptr, (bf16*)(ws + WS_WCAT) + CW, ACAT_LD, DM, 256 * nb, 256 * nb, 128 * kb, 256, 0}; return d; } r -= P0_I_BA;
    if (r < P0_I_BC) { const int kb = r / nblk, nb = r % nblk; d = P0Item{A.w_bc, nullptr, (bf16*)(ws + WS_WCAT), ACAT_LD, DM, 256 * nb, 256 * nb, 128 * kb, 256, 0}; return d; } r -= P0_I_BC;
    if (r < P0_I_OUT) { const int kb = r / nblk, nb = r % nblk; d = P0Item{A.w_out, nullptr, (bf16*)(ws + WS_WOUT), DM, DM, 256 * nb, 256 * nb, 128 * kb, 256, 0}; return d; } r -= P0_I_OUT;
    if (r < P0_I_PG) { const int kb = r / nblk, nb = r % nblk; d = P0Item{A.w_pg, A.ple_norm_g, (bf16*)(ws + WS_WPG), DM, DM, 256 * nb, 256 * nb, 128 * kb, 256, 0}; return d; } r -= P0_I_PG;
    { const int kb = r / nblk, nb = r % nblk; d = P0Item{A.w_pp, nullptr, (bf16*)(ws + WS_WPP), PLE, DM, 256 * nb, 256 * nb, 128 * kb, 256, 0}; return d; }
}
__device__ __forceinline__ void p0_items(const Args& A, LAS float* tile, int wave, int lane, int wgl, int nwg, int first, int last) {
    f32x4 va[16], vb[16]; P0Item da, db; int it = first + wgl;
    if (it < last) { da = p0_decode(A, it); p0_item_load(da, va, wave, lane); }
    while (it < last) {
        int itn = it + nwg;
        if (itn < last) { db = p0_decode(A, itn); p0_item_load(db, vb, wave, lane); }
        p0_item_store(da, va, tile, wave, lane);
        it = itn; if (it >= last) break;
        itn = it + nwg;
        if (itn < last) { da = p0_decode(A, itn); p0_item_load(da, va, wave, lane); }
        p0_item_store(db, vb, tile, wave, lane);
        it = itn;
    }
}
__device__ __forceinline__ void p0_prologue(const Frame& F, const Args& A) {
    unsigned char* ws = A.ws; const int lane = lane_id_opaque();
    const int gw = F.vcu * NWAVES + F.wave, NGW = F.G * NWAVES;
    p0_items(A, (LAS float*)(F.lds + RING_OFF), F.wave, lane, F.vcu, F.G, 0, P0_EARLY);
    { const int gt = gw * 64 + lane, NGT = NGW * 64; GAS v4u* z = (GAS v4u*)(ws + WS_WIN8 + (size_t)832 * DM);
      for (int i = gt; i < 192 * DM / 16; i += NGT) z[i] = (v4u){0u, 0u, 0u, 0u}; }
    { bf16* H = (bf16*)(ws + WS_H); const GAS f32x4* gr = (const GAS f32x4*)A.norm_g + lane;
      for (int m0 = gw; m0 < MTOK; m0 += 4 * NGW) {
        f32x4 v[4][8];
#pragma unroll
        for (int q = 0; q < 4; ++q) { const int m = m0 + q * NGW; if (m < MTOK) { const GAS f32x4* xr = (const GAS f32x4*)(A.x + (size_t)m * DM) + lane;
#pragma unroll
            for (int j = 0; j < 8; ++j) v[q][j] = xr[64 * j]; } }
#pragma unroll
        for (int q = 0; q < 4; ++q) { const int m = m0 + q * NGW; if (m < MTOK) { float s = 0.f;
#pragma unroll
            for (int j = 0; j < 8; ++j) s += (v[q][j].x * v[q][j].x + v[q][j].y * v[q][j].y) + (v[q][j].z * v[q][j].z + v[q][j].w * v[q][j].w);
            const float rs = 1.0f / sqrtf(wave_sum(s) * (1.f / DM) + EPS);
            GAS v2u* o8 = (GAS v2u*)(H + (size_t)m * DM) + lane; GAS unsigned* o4 = (GAS unsigned*)(ws + WS_H8 + (size_t)m * DM) + lane;
#pragma unroll
            for (int j = 0; j < 8; ++j) { const f32x4 g = gr[64 * j]; const float h0 = v[q][j].x * rs * g.x, h1 = v[q][j].y * rs * g.y, h2 = v[q][j].z * rs * g.z, h3 = v[q][j].w * rs * g.w;
                v2u w; w.x = pk2(h0, h1); w.y = pk2(h2, h3); o8[64 * j] = w; o4[64 * j] = pack4_fp8(h0, h1, h2, h3); } } }
      } }
    { float* COS = (float*)(ws + WS_COS); float* SIN = (float*)(ws + WS_SIN); const int gt = gw * 64 + lane, NGT = NGW * 64;
      for (int i = gt; i < MTOK * 32; i += NGT) { const int t = i >> 5, f = i & 31; const float ang = (float)A.positions[t] * inv_freq_f32(f); float s, c; sincos_acc(ang, s, c); COS[i] = c; SIN[i] = s; } }
    { bf16* PB = (bf16*)(ws + WS_PB); const int gt = gw * 64 + lane, NGT = NGW * 64;
      for (int i = gt; i < MTOK * PLE / 8; i += NGT) { const f32x4 a = ((const GAS f32x4*)A.p)[2 * i], b = ((const GAS f32x4*)A.p)[2 * i + 1];
        v4u o; o.x = pk2(a.x, a.y); o.y = pk2(a.z, a.w); o.z = pk2(b.x, b.y); o.w = pk2(b.z, b.w); ((GAS v4u*)PB)[i] = o; } }
}

using pg8::Unit;
#define EPI_ROWS_BEGIN _Pragma("unroll") for (int ai = 0; ai < 2; ++ai) _Pragma("unroll") for (int m = 0; m < 4; ++m) { const int row = u.pm * 256 + ai * 128 + wr * 64 + m * 16 + fr;
#define EPI_ROWS_END }
__device__ __forceinline__ v4u pack8(const f32x4 a, const f32x4 b) { v4u w; w.x = pg8::cvt_pk_bf16(a[0], a[1]); w.y = pg8::cvt_pk_bf16(a[2], a[3]); w.z = pg8::cvt_pk_bf16(b[0], b[1]); w.w = pg8::cvt_pk_bf16(b[2], b[3]); return w; }
__device__ __forceinline__ void unpack8_f8(const v2u w, float (&f)[8]) {
#pragma unroll
    for (int i = 0; i < 2; ++i) { const int d = (int)(i ? w.y : w.x); f[4 * i] = __builtin_amdgcn_cvt_f32_fp8(d, 0); f[4 * i + 1] = __builtin_amdgcn_cvt_f32_fp8(d, 1); f[4 * i + 2] = __builtin_amdgcn_cvt_f32_fp8(d, 2); f[4 * i + 3] = __builtin_amdgcn_cvt_f32_fp8(d, 3); }
}
__device__ __forceinline__ void unpack8(const v4u w, float (&f)[8]) { f[0] = bflo(w.x); f[1] = bfhi(w.x); f[2] = bflo(w.y); f[3] = bfhi(w.y); f[4] = bflo(w.z); f[5] = bfhi(w.z); f[6] = bflo(w.w); f[7] = bfhi(w.w); }

struct EpiZ {
    static constexpr bool PERM = true;
    unsigned char* ws; int f8;
    __device__ __forceinline__ void operator()(const f32x4 (&acc)[2][2][4][2], const Unit& u, int wr, int wc, int fr, int fq) const {
        const int cl = wc * 32 + 8 * fq;
        if (f8 && u.pn < 4) {
            if (MK_ZS_BF16) { bf16* ZSb = (bf16*)(ws + WS_ZS);
            EPI_ROWS_BEGIN  bf16* rp = ZSb + (size_t)row * 1024 + u.pn * 256 + cl;
#pragma unroll
                for (int bj = 0; bj < 2; ++bj) *(v4u*)(rp + bj * 128) = pack8(acc[ai][bj][m][0], acc[ai][bj][m][1]);  EPI_ROWS_END }
            else {
            float* ZS = (float*)(ws + WS_ZS);
            EPI_ROWS_BEGIN  float* rp = ZS + (size_t)row * 1024 + u.pn * 256 + cl;
#pragma unroll
                for (int bj = 0; bj < 2; ++bj) { *(f32x4*)(rp + bj * 128) = acc[ai][bj][m][0]; *(f32x4*)(rp + bj * 128 + 4) = acc[ai][bj][m][1]; }  EPI_ROWS_END }
        } else {
            size_t boff; int ld, c0;
            if (MK_GA_FP8 && MK_ATT_FP8 == 5 && f8 && u.pn >= 4 && u.pn < 12) {
                unsigned char* g8 = ws + WS_GA + (u.pn - 4) * 256 + cl;
                EPI_ROWS_BEGIN
#pragma unroll
                    for (int bj = 0; bj < 2; ++bj) { v2u o;
                        { f32x4 a0 = acc[ai][bj][m][0]; asm volatile("" : "+v"(a0));
                          o.x = pack4_fp8(siluf_(a0[0]) * 16.f, siluf_(a0[1]) * 16.f, siluf_(a0[2]) * 16.f, siluf_(a0[3]) * 16.f); }
                        { f32x4 a1 = acc[ai][bj][m][1]; asm volatile("" : "+v"(a1)); o.y = pack4_fp8(siluf_(a1[0]) * 16.f, siluf_(a1[1]) * 16.f, siluf_(a1[2]) * 16.f, siluf_(a1[3]) * 16.f); }
                        *(v2u*)(g8 + (size_t)row * 2048 + bj * 128) = o; }
                EPI_ROWS_END
                return; }
            if (MK_GATE_FUSE && MK_MC_FP8 && f8 && u.pn >= 12) {
                bf16* base2 = (bf16*)(ws + WS_MAMC) + (u.pn - 12) * 128 + cl;
                EPI_ROWS_BEGIN  f32x4 s0, s1, r0, r1; const f32x4 a0 = acc[ai][0][m][0], a1 = acc[ai][0][m][1], c0_ = acc[ai][1][m][0], c1_ = acc[ai][1][m][1];
#pragma unroll
                    for (int j = 0; j < 4; ++j) { const float ea0 = 1.0f + __builtin_amdgcn_exp2f(-a0[j] * LOG2E), ea1 = 1.0f + __builtin_amdgcn_exp2f(-a1[j] * LOG2E);
                        s0[j] = __builtin_amdgcn_rcpf(ea0); s1[j] = __builtin_amdgcn_rcpf(ea1);
                        r0[j] = ea0 * __builtin_amdgcn_rcpf(1.0f + __builtin_amdgcn_exp2f(-c0_[j] * LOG2E)); r1[j] = ea1 * __builtin_amdgcn_rcpf(1.0f + __builtin_amdgcn_exp2f(-c1_[j] * LOG2E)); }
                    *(v4u*)(base2 + (size_t)row * 4096) = pack8(s0, s1); *(v4u*)(base2 + (size_t)row * 4096 + 2048) = pack8(r0, r1);  EPI_ROWS_END
                return; }
            if (f8) { if (u.pn < 12) { boff = WS_GA; ld = 2048; c0 = (u.pn - 4) * 256; } else { boff = WS_MAMC; ld = 4096; c0 = (u.pn - 12) * 256; } }
            else { if (u.pn < 16) { boff = WS_CONV4; ld = 4096; c0 = u.pn * 256; } else { boff = WS_MAMC; ld = 4096; c0 = 2048 + (u.pn - 16) * 256; } }
            if (MK_CONV_FUSE && !f8 && u.pn < 16) {
                bf16* base2 = (bf16*)(ws + WS_CONV4) + (u.pn < 8 ? 0 : 1024) + (u.pn & 7) * 128 + cl; const bool isbg = u.pn >= 8;
                if (isbg) { EPI_ROWS_BEGIN  f32x4 p0 = acc[ai][0][m][0], p1 = acc[ai][0][m][1]; const f32x4 q0 = acc[ai][1][m][0], q1 = acc[ai][1][m][1];
#pragma unroll
                    for (int j = 0; j < 4; ++j) { p0[j] *= siluf_(q0[j]); p1[j] *= siluf_(q1[j]); }
                    *(v4u*)(base2 + (size_t)row * 2048) = pack8(p0, p1);  EPI_ROWS_END }
                else { EPI_ROWS_BEGIN  *(v4u*)(base2 + (size_t)row * 2048) = pack8(acc[ai][0][m][0] * acc[ai][1][m][0], acc[ai][0][m][1] * acc[ai][1][m][1]);  EPI_ROWS_END }
                return; }
            bf16* base = (bf16*)(ws + boff);
            EPI_ROWS_BEGIN  bf16* rp = base + (size_t)row * ld + c0 + cl;
#pragma unroll
                for (int bj = 0; bj < 2; ++bj) *(v4u*)(rp + bj * 128) = pack8(acc[ai][bj][m][0], acc[ai][bj][m][1]);  EPI_ROWS_END
        }
    }
};
struct EpiBf16 {
    static constexpr bool PERM = true;
    bf16* O; int ldc;
    __device__ __forceinline__ void operator()(const f32x4 (&acc)[2][2][4][2], const Unit& u, int wr, int wc, int fr, int fq) const {
        const int cl = u.pn * 256 + wc * 32 + 8 * fq;
        EPI_ROWS_BEGIN  bf16* rp = O + (size_t)row * ldc + cl;
#pragma unroll
            for (int bj = 0; bj < 2; ++bj) *(v4u*)(rp + bj * 128) = pack8(acc[ai][bj][m][0], acc[ai][bj][m][1]);  EPI_ROWS_END
    }
};
struct EpiF8 {
    static constexpr bool PERM = true;
    unsigned char* O; int ldc; float sc;
    __device__ __forceinline__ void operator()(const f32x4 (&acc)[2][2][4][2], const Unit& u, int wr, int wc, int fr, int fq) const {
        const int cl = u.pn * 256 + wc * 32 + 8 * fq;
        EPI_ROWS_BEGIN  unsigned char* rp = O + (size_t)row * ldc + cl;
#pragma unroll
            for (int bj = 0; bj < 2; ++bj) { const f32x4 a = acc[ai][bj][m][0] * sc, c = acc[ai][bj][m][1] * sc; v2u o; o.x = pack4_fp8(a[0], a[1], a[2], a[3]); o.y = pack4_fp8(c[0], c[1], c[2], c[3]); *(v2u*)(rp + bj * 128) = o; }  EPI_ROWS_END
    }
};
__device__ __forceinline__ int v_st(int k, int c) { const int kk = (k & ~0xC) | ((k & 4) << 1) | ((k & 8) >> 1); return ((kk >> 3) * 4 + (c >> 5)) * 512 + ((kk & 7) * 32 + (c & 31)) * 2; }
struct EpiKV {
    static constexpr bool PERM = true;
    bf16* KF; bf16* VT; const float* RK; const float* SSQKPE; const float* gk; LAS float* red; unsigned char* KF8lo; unsigned char* KF8hi;
    mutable int par;
    __device__ __forceinline__ void operator()(const f32x4 (&acc)[2][2][4][2], const Unit& u, int wr, int wc, int fr, int fq) const {
        const int h = u.pn; LAS float* P = red + par * 1024; par ^= 1;
        LAS unsigned char* vstage = (LAS unsigned char*)red + 8192 + (wr * 4 + wc) * 2048;
#pragma unroll
        for (int ai = 0; ai < 2; ++ai)
#pragma unroll
            for (int m = 0; m < 4; ++m) { const f32x4 a = acc[ai][0][m][0], c = acc[ai][0][m][1];
                float ss = (a[0] * a[0] + a[1] * a[1]) + (a[2] * a[2] + a[3] * a[3]) + (c[0] * c[0] + c[1] * c[1]) + (c[2] * c[2] + c[3] * c[3]);
                ss += __shfl_xor(ss, 16); ss += __shfl_xor(ss, 32);
                if (fq == 0) P[(ai * 128 + wr * 64 + m * 16 + fr) * 4 + wc] = ss; }
        asm volatile("s_waitcnt lgkmcnt(0)\n\ts_barrier" ::: "memory");
        const f32x4 g0 = *(const f32x4*)(gk + 32 * wc + 8 * fq), g1 = *(const f32x4*)(gk + 32 * wc + 8 * fq + 4);
#pragma unroll
        for (int ai = 0; ai < 2; ++ai) {
            float sk[4]; f32x4 rk4[4];
#pragma unroll
            for (int m = 0; m < 4; ++m) { const int row = u.pm * 256 + ai * 128 + wr * 64 + m * 16 + fr; sk[m] = SSQKPE[row]; rk4[m] = *(const f32x4*)(RK + (size_t)row * 64 + 16 * wc + 4 * fq); }
#pragma unroll
            for (int m = 0; m < 4; ++m) { const int row = u.pm * 256 + ai * 128 + wr * 64 + m * 16 + fr;
                const int b = row >> 11, s = row & 2047, tile = s >> 6, kr = s & 63; const size_t tb = (size_t)((b * NH + h) * 32 + tile);
                const f32x4 p4 = *(const LAS f32x4*)(P + (ai * 128 + wr * 64 + m * 16 + fr) * 4);
                const float rs = 1.0f / sqrtf((((p4[0] + p4[1]) + (p4[2] + p4[3])) + sk[m]) * (1.f / DQK) + EPS);
                const f32x4 kn0 = acc[ai][0][m][0] * g0 * rs, kn1 = acc[ai][0][m][1] * g1 * rs; const f32x4 r4 = rk4[m] * rs;
                if (MK_ATT_FP8 == 0 || MK_ATT_FP8 == 2) {
                    *(v4u*)(KF + tb * 12288 + (4 * wc + fq) * 512 + kr * 8) = pack8(kn0, kn1);
                    v2u w; w.x = pg8::cvt_pk_bf16(r4[0], r4[1]); w.y = pg8::cvt_pk_bf16(r4[2], r4[3]);
                    *(v2u*)(KF + tb * 12288 + (16 + 2 * wc + (fq >> 1)) * 512 + kr * 8 + (fq & 1) * 4) = w; }
                if (MK_ATT_FP8 != 0) {
                    unsigned char* k8 = (b < 2 ? KF8lo : KF8hi) + (size_t)(((b & 1) * NH + h) * 32 + tile) * 12288 + kr * 16;
                    v2u w8; w8.x = pack4_fp8(kn0[0], kn0[1], kn0[2], kn0[3]); w8.y = pack4_fp8(kn1[0], kn1[1], kn1[2], kn1[3]);
                    *(v2u*)(k8 + (2 * wc + (fq >> 1)) * 1024 + 8 * (fq & 1)) = w8;
                    *(unsigned*)(k8 + ((4 + (wc & 1)) * 2 + (wc >> 1)) * 1024 + 4 * fq) = pack4_fp8(r4[0], r4[1], r4[2], r4[3]); }
                if (MK_ATT_FP8 < 3) *(v4u*)((unsigned char*)VT + tb * 16384 + v_st(kr, 32 * wc + 8 * fq)) = pack8(acc[ai][1][m][0], acc[ai][1][m][1]);
                else {
                    const f32x4 v0 = acc[ai][1][m][0], v1 = acc[ai][1][m][1];
                    const unsigned w0 = pack4_fp8(v0[0], v0[1], v0[2], v0[3]), w1 = pack4_fp8(v1[0], v1[1], v1[2], v1[3]);
                    LAS unsigned char* vp = vstage + ((((kr >> 2) & 1) * 2 + (kr >> 5)) * 32 + 8 * fq) * 16 + (((kr >> 3) & 3) * 4 + (kr & 3));
                    vp[0] = (unsigned char)w0; vp[16] = (unsigned char)(w0 >> 8); vp[32] = (unsigned char)(w0 >> 16); vp[48] = (unsigned char)(w0 >> 24);
                    vp[64] = (unsigned char)w1; vp[80] = (unsigned char)(w1 >> 8); vp[96] = (unsigned char)(w1 >> 16); vp[112] = (unsigned char)(w1 >> 24); } }
            if (MK_ATT_FP8 >= 3) {
                const int row0 = u.pm * 256 + ai * 128 + wr * 64; const size_t tb0 = (size_t)(((row0 >> 11) * NH + h) * 32 + ((row0 & 2047) >> 6));
                asm volatile("s_waitcnt lgkmcnt(0)" ::: "memory");
                const int l2_ = (fq << 4) | fr; const v4u x0 = *(const LAS v4u*)(vstage + 32 * l2_), x1 = *(const LAS v4u*)(vstage + 32 * l2_ + 16);
                unsigned char* gp = (unsigned char*)VT + tb0 * 8192 + wc * 2048 + 32 * l2_;
                *(v4u*)gp = x0; *(v4u*)(gp + 16) = x1;
                asm volatile("s_waitcnt lgkmcnt(0)" ::: "memory"); }
        }
    }
};
#define EPI_PAIR_BEGIN _Pragma("unroll") for (int gp = 0; gp < 4; ++gp) {
#define EPI_PAIR_END }
#define EPI_ROW_OF(g) (u.pm * 256 + (((gp) * 2 + (g)) >> 2) * 128 + wr * 64 + (((gp) * 2 + (g)) & 3) * 16 + fr)
#define EPI_ACC(g, bj, n) acc[((gp) * 2 + (g)) >> 2][bj][((gp) * 2 + (g)) & 3][n]
struct EpiMerge2 {
    static constexpr bool PERM = true;
    const bf16* MAMC; bf16* MG;
    __device__ __forceinline__ void mid(f32x4 (&acc)[2][2][4][2], const Unit& u, int wr, int wc, int fr, int fq) const {
        const int cl = u.pn * 256 + wc * 32 + 8 * fq; const bf16* __restrict__ mamc = MAMC;
        EPI_PAIR_BEGIN
            v4u av[2][2], cv[2][2];
#pragma unroll
            for (int g = 0; g < 2; ++g)
#pragma unroll
                for (int bj = 0; bj < 2; ++bj) { const bf16* p = mamc + (size_t)EPI_ROW_OF(g) * 4096 + cl + bj * 128; if (!(MK_GATE_FUSE && MK_MC_FP8)) av[g][bj] = *(const v4u*)p; cv[g][bj] = *(const v4u*)(p + 2048); }
#pragma unroll
            for (int g = 0; g < 2; ++g)
#pragma unroll
                for (int bj = 0; bj < 2; ++bj) { float ga[8], gc[8]; unpack8(cv[g][bj], gc);
                    if (MK_GATE_FUSE && MK_MC_FP8) {
#pragma unroll
                        for (int j = 0; j < 4; ++j) { EPI_ACC(g, bj, 0)[j] *= gc[j]; EPI_ACC(g, bj, 1)[j] *= gc[4 + j]; }
                        continue; }
                    unpack8(av[g][bj], ga);
#pragma unroll
                    for (int j = 0; j < 4; ++j) {
                        EPI_ACC(g, bj, 0)[j] *= (1.0f + __builtin_amdgcn_exp2f(-ga[j] * LOG2E)) * __builtin_amdgcn_rcpf(1.0f + __builtin_amdgcn_exp2f(-gc[j] * LOG2E));
                        EPI_ACC(g, bj, 1)[j] *= (1.0f + __builtin_amdgcn_exp2f(-ga[4 + j] * LOG2E)) * __builtin_amdgcn_rcpf(1.0f + __builtin_amdgcn_exp2f(-gc[4 + j] * LOG2E)); } }
        EPI_PAIR_END
    }
    __device__ __forceinline__ void operator()(const f32x4 (&acc)[2][2][4][2], const Unit& u, int wr, int wc, int fr, int fq) const {
        const int cl = u.pn * 256 + wc * 32 + 8 * fq; const bf16* __restrict__ mamc = MAMC; bf16* __restrict__ mg = MG;
        EPI_PAIR_BEGIN
            v4u gv[2][2];
#pragma unroll
            for (int g = 0; g < 2; ++g)
#pragma unroll
                for (int bj = 0; bj < 2; ++bj) gv[g][bj] = *(const v4u*)(mamc + (size_t)EPI_ROW_OF(g) * 4096 + cl + bj * 128);
#pragma unroll
            for (int g = 0; g < 2; ++g)
#pragma unroll
                for (int bj = 0; bj < 2; ++bj) { float gg[8]; unpack8(gv[g][bj], gg); f32x4 a = EPI_ACC(g, bj, 0), c = EPI_ACC(g, bj, 1);
#pragma unroll
                    for (int j = 0; j < 4; ++j) { a[j] *= (MK_GATE_FUSE && MK_MC_FP8) ? gg[j] : sigmoidf_(gg[j]); c[j] *= (MK_GATE_FUSE && MK_MC_FP8) ? gg[4 + j] : sigmoidf_(gg[4 + j]); }
                    *(v4u*)(mg + (size_t)EPI_ROW_OF(g) * 2048 + cl + bj * 128) = pack8(a, c); }
        EPI_PAIR_END
    }
};
struct EpiX1 {
    static constexpr bool PERM = true;
    const float* X; float* X1F; bf16* X1G; float* SSQ1P;
    __device__ __forceinline__ void operator()(const f32x4 (&acc)[2][2][4][2], const Unit& u, int wr, int wc, int fr, int fq) const {
        const int cl = u.pn * 256 + wc * 32 + 8 * fq; const float* __restrict__ x = X; float* __restrict__ x1f = X1F; bf16* __restrict__ x1g = X1G;
        EPI_PAIR_BEGIN
            f32x4 xv[2][2][2];
#pragma unroll
            for (int g = 0; g < 2; ++g)
#pragma unroll
                for (int bj = 0; bj < 2; ++bj) { const size_t off = (size_t)EPI_ROW_OF(g) * 2048 + cl + bj * 128; xv[g][bj][0] = *(const f32x4*)(x + off); xv[g][bj][1] = *(const f32x4*)(x + off + 4); }
#pragma unroll
            for (int g = 0; g < 2; ++g) { float ss = 0.f; const int row = EPI_ROW_OF(g);
#pragma unroll
                for (int bj = 0; bj < 2; ++bj) { const size_t off = (size_t)row * 2048 + cl + bj * 128;
                    const f32x4 a = xv[g][bj][0] + EPI_ACC(g, bj, 0), c = xv[g][bj][1] + EPI_ACC(g, bj, 1);
                    if (!MK_X1_BF16) { *(f32x4*)(x1f + off) = a; *(f32x4*)(x1f + off + 4) = c; } *(v4u*)(x1g + off) = pack8(a, c);
                    ss += (a[0] * a[0] + a[1] * a[1]) + (a[2] * a[2] + a[3] * a[3]) + (c[0] * c[0] + c[1] * c[1]) + (c[2] * c[2] + c[3] * c[3]); }
                ss += __shfl_xor(ss, 16); ss += __shfl_xor(ss, 32);
                if (fq == 0) SSQ1P[(size_t)row * 32 + u.pn * 4 + wc] = ss; }
        EPI_PAIR_END
    }
};
struct EpiOut {
    static constexpr bool PERM = true;
    const float* X1F; float* OUT; const bf16* PPROJ; const float* SSQ1P; const bf16* X1G;
    __device__ __forceinline__ void operator()(const f32x4 (&acc)[2][2][4][2], const Unit& u, int wr, int wc, int fr, int fq) const {
        const int cl = u.pn * 256 + wc * 32 + 8 * fq; const float* __restrict__ x1f = X1F; float* __restrict__ out = OUT; const bf16* __restrict__ pp = PPROJ; const float* __restrict__ sq = SSQ1P;
        EPI_PAIR_BEGIN
            f32x4 xv[2][2][2]; v4u xg[2][2]; v4u pv[2][2]; f32x4 sv[2][2];
#pragma unroll
            for (int g = 0; g < 2; ++g) { const int row = EPI_ROW_OF(g);
#pragma unroll
                for (int j = 0; j < 2; ++j) sv[g][j] = *(const f32x4*)(sq + (size_t)row * 32 + 8 * fq + 4 * j);
#pragma unroll
                for (int bj = 0; bj < 2; ++bj) { const size_t off = (size_t)row * 2048 + cl + bj * 128; if (MK_X1_BF16) xg[g][bj] = *(const v4u*)(X1G + off); else { xv[g][bj][0] = *(const f32x4*)(x1f + off); xv[g][bj][1] = *(const f32x4*)(x1f + off + 4); } pv[g][bj] = *(const v4u*)(pp + off); } }
#pragma unroll
            for (int g = 0; g < 2; ++g) { float ss = 0.f;
#pragma unroll
                for (int j = 0; j < 2; ++j) ss += (sv[g][j][0] + sv[g][j][1]) + (sv[g][j][2] + sv[g][j][3]);
                ss += __shfl_xor(ss, 16); ss += __shfl_xor(ss, 32);
                const float r1 = 1.0f / sqrtf(ss * (1.f / DM) + EPS);
#pragma unroll
                for (int bj = 0; bj < 2; ++bj) { const size_t off = (size_t)EPI_ROW_OF(g) * 2048 + cl + bj * 128; float p[8]; unpack8(pv[g][bj], p);
                    f32x4 a, c; if (MK_X1_BF16) { float x8[8]; unpack8(xg[g][bj], x8); a = (f32x4){x8[0], x8[1], x8[2], x8[3]}; c = (f32x4){x8[4], x8[5], x8[6], x8[7]}; } else { a = xv[g][bj][0]; c = xv[g][bj][1]; }
                    const f32x4 ga = EPI_ACC(g, bj, 0), gc = EPI_ACC(g, bj, 1);
#pragma unroll
                    for (int j = 0; j < 4; ++j) { a[j] += sigmoidf_(r1 * ga[j]) * p[j]; c[j] += sigmoidf_(r1 * gc[j]) * p[4 + j]; }
                    *(f32x4*)(out + off) = a; *(f32x4*)(out + off + 4) = c; } }
        EPI_PAIR_END
    }
};

#define EPI_I(gp, g) ((gp) * 2 + (g))
#define EPI_ROW_I(i) (u.pm * 256 + ((i) >> 2) * 128 + wr * 64 + ((i) & 3) * 16 + fr)
#define EPI_ACC_I(i, bj, n) acc[(i) >> 2][bj][(i) & 3][n]
struct EpiMerge2P {
    static constexpr bool PERM = true;
    const bf16* MAMC; bf16* MG;
    __device__ __forceinline__ void mid(f32x4 (&acc)[2][2][4][2], const Unit& u, int wr, int wc, int fr, int fq) const {
        const int cl = u.pn * 256 + wc * 32 + 8 * fq; const bf16* mamc = MAMC + 2048 + cl;
        v4u cb[2][2][2];
#define LD_(B, GP) _Pragma("unroll") for (int g = 0; g < 2; ++g) _Pragma("unroll") for (int bj = 0; bj < 2; ++bj) cb[B][g][bj] = *(const v4u*)(mamc + (size_t)EPI_ROW_I(EPI_I(GP, g)) * 4096 + bj * 128)
        LD_(0, 0);
#pragma unroll
        for (int gp = 0; gp < 4; ++gp) { if (gp < 3) { LD_((gp + 1) & 1, gp + 1); }
#pragma unroll
            for (int g = 0; g < 2; ++g)
#pragma unroll
                for (int bj = 0; bj < 2; ++bj) { float gc[8]; unpack8(cb[gp & 1][g][bj], gc);
#pragma unroll
                    for (int j = 0; j < 4; ++j) { EPI_ACC_I(EPI_I(gp, g), bj, 0)[j] *= gc[j]; EPI_ACC_I(EPI_I(gp, g), bj, 1)[j] *= gc[4 + j]; } } }
#undef LD_
    }
    __device__ __forceinline__ void operator()(const f32x4 (&acc)[2][2][4][2], const Unit& u, int wr, int wc, int fr, int fq) const {
        const int cl = u.pn * 256 + wc * 32 + 8 * fq; const bf16* mamc = MAMC + cl; bf16* mg = MG + cl;
        v4u gb[2][2][2];
#define LD_(B, GP) _Pragma("unroll") for (int g = 0; g < 2; ++g) _Pragma("unroll") for (int bj = 0; bj < 2; ++bj) gb[B][g][bj] = *(const v4u*)(mamc + (size_t)EPI_ROW_I(EPI_I(GP, g)) * 4096 + bj * 128)
        LD_(0, 0);
#pragma unroll
        for (int gp = 0; gp < 4; ++gp) { if (gp < 3) { LD_((gp + 1) & 1, gp + 1); }
#pragma unroll
            for (int g = 0; g < 2; ++g)
#pragma unroll
                for (int bj = 0; bj < 2; ++bj) { float gg[8]; unpack8(gb[gp & 1][g][bj], gg); f32x4 a = EPI_ACC_I(EPI_I(gp, g), bj, 0), c = EPI_ACC_I(EPI_I(gp, g), bj, 1);
#pragma unroll
                    for (int j = 0; j < 4; ++j) { a[j] *= gg[j]; c[j] *= gg[4 + j]; }
                    *(v4u*)(mg + (size_t)EPI_ROW_I(EPI_I(gp, g)) * 2048 + bj * 128) = pack8(a, c); } }
#undef LD_
    }
};
struct EpiX1P {
    static constexpr bool PERM = true;
    const float* X; float* X1F; bf16* X1G; float* SSQ1P;
    __device__ __forceinline__ void operator()(const f32x4 (&acc)[2][2][4][2], const Unit& u, int wr, int wc, int fr, int fq) const {
        const int cl = u.pn * 256 + wc * 32 + 8 * fq; const float* x = X + cl; bf16* x1g = X1G + cl;
        f32x4 xb[2][2][2][2];
#define LD_(B, GP) _Pragma("unroll") for (int g = 0; g < 2; ++g) _Pragma("unroll") for (int bj = 0; bj < 2; ++bj) { const float* p_ = x + (size_t)EPI_ROW_I(EPI_I(GP, g)) * 2048 + bj * 128; xb[B][g][bj][0] = *(const f32x4*)p_; xb[B][g][bj][1] = *(const f32x4*)(p_ + 4); }
        LD_(0, 0);
#pragma unroll
        for (int gp = 0; gp < 4; ++gp) { if (gp < 3) { LD_((gp + 1) & 1, gp + 1); }
#pragma unroll
            for (int g = 0; g < 2; ++g) { float ss = 0.f; const int row = EPI_ROW_I(EPI_I(gp, g));
#pragma unroll
                for (int bj = 0; bj < 2; ++bj) { const f32x4 a = xb[gp & 1][g][bj][0] + EPI_ACC_I(EPI_I(gp, g), bj, 0), c = xb[gp & 1][g][bj][1] + EPI_ACC_I(EPI_I(gp, g), bj, 1);
                    *(v4u*)(x1g + (size_t)row * 2048 + bj * 128) = pack8(a, c);
                    ss += (a[0] * a[0] + a[1] * a[1]) + (a[2] * a[2] + a[3] * a[3]) + (c[0] * c[0] + c[1] * c[1]) + (c[2] * c[2] + c[3] * c[3]); }
                ss += __shfl_xor(ss, 16); ss += __shfl_xor(ss, 32);
                if (fq == 0) SSQ1P[(size_t)row * 32 + u.pn * 4 + wc] = ss; } }
#undef LD_
    }
};
struct EpiOutP {
    static constexpr bool PERM = true;
    const float* X1F; float* OUT; const bf16* PPROJ; const float* SSQ1P; const bf16* X1G;
    __device__ __forceinline__ void operator()(const f32x4 (&acc)[2][2][4][2], const Unit& u, int wr, int wc, int fr, int fq) const {
        const int cl = u.pn * 256 + wc * 32 + 8 * fq; float* out = OUT + cl; const bf16* pp = PPROJ + cl; const bf16* xg_ = X1G + cl; const float* sq = SSQ1P + 8 * fq;
        v4u xb[2][2], pb[2][2]; f32x4 sb[2][2];
#define LD_(B, I) { const int row_ = EPI_ROW_I(I); sb[B][0] = *(const f32x4*)(sq + (size_t)row_ * 32); sb[B][1] = *(const f32x4*)(sq + (size_t)row_ * 32 + 4); \
            _Pragma("unroll") for (int bj = 0; bj < 2; ++bj) { xb[B][bj] = *(const v4u*)(xg_ + (size_t)row_ * 2048 + bj * 128); pb[B][bj] = *(const v4u*)(pp + (size_t)row_ * 2048 + bj * 128); } }
        LD_(0, 0);
#pragma unroll
        for (int i = 0; i < 8; ++i) { if (i < 7) { LD_((i + 1) & 1, i + 1); }
            const int row = EPI_ROW_I(i); const f32x4 s0 = sb[i & 1][0], s1 = sb[i & 1][1];
            float ss = ((s0[0] + s0[1]) + (s0[2] + s0[3])) + ((s1[0] + s1[1]) + (s1[2] + s1[3]));
            ss += __shfl_xor(ss, 16); ss += __shfl_xor(ss, 32);
            const float r1 = 1.0f / sqrtf(ss * (1.f / DM) + EPS);
#pragma unroll
            for (int bj = 0; bj < 2; ++bj) { float p[8], x8[8]; unpack8(pb[i & 1][bj], p); unpack8(xb[i & 1][bj], x8);
                f32x4 a = (f32x4){x8[0], x8[1], x8[2], x8[3]}, c = (f32x4){x8[4], x8[5], x8[6], x8[7]}; const f32x4 ga = EPI_ACC_I(i, bj, 0), gc = EPI_ACC_I(i, bj, 1);
#pragma unroll
                for (int j = 0; j < 4; ++j) { a[j] += sigmoidf_(r1 * ga[j]) * p[j]; c[j] += sigmoidf_(r1 * gc[j]) * p[4 + j]; }
                float* o_ = out + (size_t)row * 2048 + bj * 128; *(f32x4*)o_ = a; *(f32x4*)(o_ + 4) = c; } }
#undef LD_
    }
};

__device__ __forceinline__ void p2_rowpass(const Frame& F, const Args& A) {
    unsigned char* ws = A.ws;
    const float* ZS = (const float*)(ws + WS_ZS); const bf16* CONV4 = (const bf16*)(ws + WS_CONV4);
    bf16* QLAT = (bf16*)(ws + WS_QLAT); bf16* KVLAT = (bf16*)(ws + WS_KVLAT); float* RK = (float*)(ws + WS_RK); float* SSQKPE = (float*)(ws + WS_SSQKPE); bf16* CVG = (bf16*)((unsigned char*)A.out + OUT_ACAT);
    const float* COS = (const float*)(ws + WS_COS); const float* SIN = (const float*)(ws + WS_SIN);
    const int gw = F.vcu * NWAVES + F.wave, NGW = F.G * NWAVES, lane = lane_id_opaque();
    for (int t0 = 4 * gw; t0 < MTOK; t0 += 4 * NGW) {
        { f32x4 qa[4], qb[4], ka[4]; float kp[4], cs[4], sn[4]; const int fi = lane & 31;
#pragma unroll
          for (int q = 0; q < 4; ++q) {
              if (MK_ZS_BF16) { const bf16* zb = (const bf16*)ZS + (size_t)(t0 + q) * 1024; const v2u a2 = *(const v2u*)(zb + 4 * lane), b2 = *(const v2u*)(zb + 256 + 4 * lane), c2 = *(const v2u*)(zb + 512 + 4 * lane);
                  qa[q] = (f32x4){bflo(a2.x), bfhi(a2.x), bflo(a2.y), bfhi(a2.y)}; qb[q] = (f32x4){bflo(b2.x), bfhi(b2.x), bflo(b2.y), bfhi(b2.y)}; ka[q] = (f32x4){bflo(c2.x), bfhi(c2.x), bflo(c2.y), bfhi(c2.y)};
                  kp[q] = bflo((unsigned)zb[768 + lane]); }
              else { const float* zr = ZS + (size_t)(t0 + q) * 1024; qa[q] = *(const f32x4*)(zr + 4 * lane); qb[q] = *(const f32x4*)(zr + 256 + 4 * lane); ka[q] = *(const f32x4*)(zr + 512 + 4 * lane);
              kp[q] = zr[768 + lane]; }
              cs[q] = COS[(size_t)(t0 + q) * 32 + fi]; sn[q] = SIN[(size_t)(t0 + q) * 32 + fi]; }
          const float gk = A.k_norm_g[DNOPE + lane];
#pragma unroll
          for (int q = 0; q < 4; ++q) { const int t = t0 + q; const f32x4 a = qa[q], b = qb[q], c = ka[q];
              float s = (a[0] * a[0] + a[1] * a[1]) + (a[2] * a[2] + a[3] * a[3]) + (b[0] * b[0] + b[1] * b[1]) + (b[2] * b[2] + b[3] * b[3]);
              const float rs = 1.0f / sqrtf(wave_sum(s) * (1.f / QR) + EPS);
              { unsigned char* q8 = (unsigned char*)QLAT + (size_t)t * QR;
                *(unsigned*)(q8 + 4 * lane) = pack4_fp8(a[0] * rs, a[1] * rs, a[2] * rs, a[3] * rs); *(unsigned*)(q8 + 256 + 4 * lane) = pack4_fp8(b[0] * rs, b[1] * rs, b[2] * rs, b[3] * rs); }
              float s2 = (c[0] * c[0] + c[1] * c[1]) + (c[2] * c[2] + c[3] * c[3]);
              const float rk = 1.0f / sqrtf(wave_sum(s2) * (1.f / KVR) + EPS);
              v2u w2; w2.x = pk2(c[0] * rk, c[1] * rk); w2.y = pk2(c[2] * rk, c[3] * rk);
              *(v2u*)(KVLAT + (size_t)t * KVR + 4 * lane) = w2;
              const float ssq = wave_sum(kp[q] * kp[q]); const float v = kp[q] * gk; const float vo = __shfl_xor(v, 32);
              RK[(size_t)t * 64 + lane] = (lane < 32) ? (v * cs[q] - vo * sn[q]) : (v * cs[q] + vo * sn[q]);
              if (lane == 0) SSQKPE[t] = ssq; } }
        if (!MK_CONV_FUSE)
        { const int sq0 = t0 & (SEQ - 1); const bool hasp = sq0 > 0, hasn = sq0 + 4 < SEQ;
          const bf16* r0 = CONV4 + (size_t)t0 * 4096;
#pragma unroll
          for (int ch = 0; ch < 2; ++ch) { const int c0 = ch * 512 + 8 * lane;
            v4u rc[6], rx[6], rb[4], rg[4];
#pragma unroll
            for (int q = 0; q < 6; ++q) { const bool ok = (q == 0) ? hasp : ((q == 5) ? hasn : true);
                if (ok) { rc[q] = *(const v4u*)(r0 + (ptrdiff_t)(q - 1) * 4096 + 1024 + c0); rx[q] = *(const v4u*)(r0 + (ptrdiff_t)(q - 1) * 4096 + 2048 + c0); } else { rc[q] = (v4u){0u, 0u, 0u, 0u}; rx[q] = (v4u){0u, 0u, 0u, 0u}; } }
#pragma unroll
            for (int q = 0; q < 4; ++q) { rb[q] = *(const v4u*)(r0 + (size_t)q * 4096 + c0); rg[q] = *(const v4u*)(r0 + (size_t)q * 4096 + 3072 + c0); }
            const f32x4 w0a = *(const f32x4*)(A.conv_w + c0), w0b = *(const f32x4*)(A.conv_w + c0 + 4), w1a = *(const f32x4*)(A.conv_w + 1024 + c0), w1b = *(const f32x4*)(A.conv_w + 1024 + c0 + 4),
                        w2a = *(const f32x4*)(A.conv_w + 2048 + c0), w2b = *(const f32x4*)(A.conv_w + 2048 + c0 + 4), bba = *(const f32x4*)(A.conv_b + c0), bbb = *(const f32x4*)(A.conv_b + c0 + 4);
            float u[6][8];
#pragma unroll
            for (int q = 0; q < 6; ++q) { float c8[8], x8[8]; unpack8(rc[q], c8); unpack8(rx[q], x8);
#pragma unroll
                for (int j = 0; j < 8; ++j) u[q][j] = c8[j] * x8[j]; }
#pragma unroll
            for (int q = 0; q < 4; ++q) { float cb[8], gc[8], o[8]; unpack8(rb[q], cb); unpack8(rg[q], gc);
#pragma unroll
                for (int j = 0; j < 8; ++j) { const float w0 = j < 4 ? w0a[j] : w0b[j - 4], w1 = j < 4 ? w1a[j] : w1b[j - 4], w2 = j < 4 ? w2a[j] : w2b[j - 4], bb = j < 4 ? bba[j] : bbb[j - 4];
                    const float cv = cb[j] * (u[q][j] * w0 + u[q + 1][j] * w1 + u[q + 2][j] * w2 + bb);
                    o[j] = cv * siluf_(gc[j]); }
                v4u w; w.x = pk2(o[0], o[1]); w.y = pk2(o[2], o[3]); w.z = pk2(o[4], o[5]); w.w = pk2(o[6], o[7]);
                *(v4u*)(CVG + (size_t)(t0 + q) * ACAT_LD + c0) = w; } } }
        if (MK_CONV_FUSE)
        { const int sq0 = t0 & (SEQ - 1); const bool hasp = sq0 > 0, hasn = sq0 + 4 < SEQ;
          const bf16* r0 = CONV4 + (size_t)t0 * 2048;
#pragma unroll
          for (int ch = 0; ch < 2; ++ch) { const int c0 = ch * 512 + 8 * lane;
            v4u ru[6], rbg[4];
#pragma unroll
            for (int q = 0; q < 6; ++q) { const bool ok = (q == 0) ? hasp : ((q == 5) ? hasn : true);
                if (ok) ru[q] = *(const v4u*)(r0 + (ptrdiff_t)(q - 1) * 2048 + c0); else ru[q] = (v4u){0u, 0u, 0u, 0u}; }
#pragma unroll
            for (int q = 0; q < 4; ++q) rbg[q] = *(const v4u*)(r0 + (size_t)q * 2048 + 1024 + c0);
            const f32x4 w0a = *(const f32x4*)(A.conv_w + c0), w0b = *(const f32x4*)(A.conv_w + c0 + 4), w1a = *(const f32x4*)(A.conv_w + 1024 + c0), w1b = *(const f32x4*)(A.conv_w + 1024 + c0 + 4),
                        w2a = *(const f32x4*)(A.conv_w + 2048 + c0), w2b = *(const f32x4*)(A.conv_w + 2048 + c0 + 4), bba = *(const f32x4*)(A.conv_b + c0), bbb = *(const f32x4*)(A.conv_b + c0 + 4);
            float u[6][8];
#pragma unroll
            for (int q = 0; q < 6; ++q) unpack8(ru[q], u[q]);
#pragma unroll
            for (int q = 0; q < 4; ++q) { float bg[8], o[8]; unpack8(rbg[q], bg);
#pragma unroll
                for (int j = 0; j < 8; ++j) { const float w0 = j < 4 ? w0a[j] : w0b[j - 4], w1 = j < 4 ? w1a[j] : w1b[j - 4], w2 = j < 4 ? w2a[j] : w2b[j - 4], bb = j < 4 ? bba[j] : bbb[j - 4];
                    o[j] = bg[j] * (u[q][j] * w0 + u[q + 1][j] * w1 + u[q + 2][j] * w2 + bb); }
                v4u w; w.x = pk2(o[0], o[1]); w.y = pk2(o[2], o[3]); w.z = pk2(o[4], o[5]); w.w = pk2(o[6], o[7]);
                *(v4u*)(CVG + (size_t)(t0 + q) * ACAT_LD + c0) = w; } } }
    }
}

namespace att {
constexpr int KT_BYTES = 24576, VT_BYTES = 16384;
constexpr int NSLOT = 3, L_K = 0, L_V = NSLOT * KT_BYTES, L_WS = L_V + NSLOT * VT_BYTES, L_END = L_WS + NWAVES * 256;
static_assert(L_END <= RING_BYTES, "attention LDS");
constexpr float THR2 = 8.f * LOG2E;
#define SBAR() __builtin_amdgcn_sched_barrier(0)
__device__ __forceinline__ int crow(int r, int hi) { return (r & 3) + 8 * (r >> 2) + 4 * hi; }
__device__ __forceinline__ unsigned cvtpk(float lo, float hi) { unsigned r; asm volatile("v_cvt_pk_bf16_f32 %0, %1, %2" : "=v"(r) : "v"(lo), "v"(hi)); return r; }

__device__ __forceinline__ void partialSM(f32x16& p0, f32x16& p1, float& m_reg, float& alpha) {
    float pmax = p0[0];
#pragma unroll
    for (int r = 1; r < 16; ++r) pmax = fmaxf(pmax, p0[r]);
#pragma unroll
    for (int r = 0; r < 16; ++r) pmax = fmaxf(pmax, p1[r]);
    { auto rr = __builtin_amdgcn_permlane32_swap(__float_as_uint(pmax), __float_as_uint(pmax), false, false);
      pmax = fmaxf(__uint_as_float(rr[0]), __uint_as_float(rr[1])); }
    float mn;
    if (__builtin_expect(__all(pmax - m_reg <= THR2), 1)) { mn = m_reg; alpha = 1.f; }
    else { mn = fmaxf(m_reg, pmax); alpha = __builtin_amdgcn_exp2f(m_reg - mn); m_reg = mn; }
#pragma unroll
    for (int r = 0; r < 16; ++r) p0[r] = p0[r] - mn;
#pragma unroll
    for (int r = 0; r < 16; ++r) p1[r] = p1[r] - mn;
#pragma unroll
    for (int r = 0; r < 16; ++r) p0[r] = __builtin_amdgcn_exp2f(p0[r]);
}
__device__ __forceinline__ void finishSM(f32x16& p0, f32x16& p1, float alpha, float& l_reg, bf16x8& pa0, bf16x8& pa1, bf16x8& pa2, bf16x8& pa3) {
#pragma unroll
    for (int r = 0; r < 16; ++r) p1[r] = __builtin_amdgcn_exp2f(p1[r]);
    float ps = 0;
#pragma unroll
    for (int r = 0; r < 16; ++r) ps += p0[r];
#pragma unroll
    for (int r = 0; r < 16; ++r) ps += p1[r];
    { auto rr = __builtin_amdgcn_permlane32_swap(__float_as_uint(ps), __float_as_uint(ps), false, false);
      ps = __uint_as_float(rr[0]) + __uint_as_float(rr[1]); }
    l_reg = l_reg * alpha + ps;
#define PK4(P, BASE, OUT) do { unsigned a0 = cvtpk(P[BASE + 0], P[BASE + 1]), a1 = cvtpk(P[BASE + 2], P[BASE + 3]);   \
    unsigned b0 = cvtpk(P[BASE + 4], P[BASE + 5]), b1 = cvtpk(P[BASE + 6], P[BASE + 7]);                              \
    auto r0 = __builtin_amdgcn_permlane32_swap(a0, b0, false, false); auto r1 = __builtin_amdgcn_permlane32_swap(a1, b1, false, false); \
    v4u w = {r0[0], r1[0], r0[1], r1[1]}; OUT = __builtin_bit_cast(bf16x8, w); } while (0)
    PK4(p0, 0, pa0); PK4(p0, 8, pa1); PK4(p1, 0, pa2); PK4(p1, 8, pa3);
#undef PK4
}
__device__ __forceinline__ void qkt(f32x16& p0, f32x16& p1, const LAS unsigned char* Ks, const bf16x8 (&qr)[12], int r32, int hi) {
    p0 = f32x16{}; p1 = f32x16{};
#pragma unroll
    for (int d0 = 0; d0 < 12; ++d0) {
        const bf16x8 b0 = *(const LAS bf16x8*)(Ks + (2 * d0 + hi) * 1024 + r32 * 16);
        const bf16x8 b1 = *(const LAS bf16x8*)(Ks + (2 * d0 + hi) * 1024 + (32 + r32) * 16);
        p0 = __builtin_amdgcn_mfma_f32_32x32x16_bf16(b0, qr[d0], p0, 0, 0, 0);
        p1 = __builtin_amdgcn_mfma_f32_32x32x16_bf16(b1, qr[d0], p1, 0, 0, 0); }
}
__device__ __forceinline__ int v_rd_base(int lane) { return ((lane & 3) << 3) | (((lane >> 2) & 3) << 6) | (((lane >> 4) & 1) << 5) | (((lane >> 5) & 1) << 8); }
constexpr int v_rd_off(int d0, int ks, int half) { return d0 * 512 + ks * 4096 + half * 2048; }
template <int OFF> __device__ __forceinline__ s16x4 tr_read(int vb) {
    s16x4 r; asm volatile("ds_read_b64_tr_b16 %0, %1 offset:%2" : "=&v"(r) : "v"(vb), "i"(OFF) : "memory"); return r;
}
template <int D0> __device__ __forceinline__ void pv_one(f32x16& od, int vb, bf16x8 pa0, bf16x8 pa1, bf16x8 pa2, bf16x8 pa3) {
    const s16x4 l0 = tr_read<v_rd_off(D0, 0, 0)>(vb), h0 = tr_read<v_rd_off(D0, 0, 1)>(vb), l1 = tr_read<v_rd_off(D0, 1, 0)>(vb), h1 = tr_read<v_rd_off(D0, 1, 1)>(vb);
    const s16x4 l2 = tr_read<v_rd_off(D0, 2, 0)>(vb), h2 = tr_read<v_rd_off(D0, 2, 1)>(vb), l3 = tr_read<v_rd_off(D0, 3, 0)>(vb), h3 = tr_read<v_rd_off(D0, 3, 1)>(vb);
    asm volatile("s_waitcnt lgkmcnt(0)" ::: "memory"); SBAR();
#define PK(L, H) (bf16x8){L[0], L[1], L[2], L[3], H[0], H[1], H[2], H[3]}
    od = __builtin_amdgcn_mfma_f32_32x32x16_bf16(pa0, PK(l0, h0), od, 0, 0, 0);
    od = __builtin_amdgcn_mfma_f32_32x32x16_bf16(pa1, PK(l1, h1), od, 0, 0, 0);
    od = __builtin_amdgcn_mfma_f32_32x32x16_bf16(pa2, PK(l2, h2), od, 0, 0, 0);
    od = __builtin_amdgcn_mfma_f32_32x32x16_bf16(pa3, PK(l3, h3), od, 0, 0, 0);
#undef PK
}
__device__ __forceinline__ void pv_d0(f32x16 (&o)[4], int vb, bf16x8 pa0, bf16x8 pa1, bf16x8 pa2, bf16x8 pa3) {
    pv_one<0>(o[0], vb, pa0, pa1, pa2, pa3); pv_one<1>(o[1], vb, pa0, pa1, pa2, pa3); pv_one<2>(o[2], vb, pa0, pa1, pa2, pa3); pv_one<3>(o[3], vb, pa0, pa1, pa2, pa3);
}

template <int D0> __device__ __forceinline__ void pv_reads(int vb, s16x4 (&l)[4], s16x4 (&h)[4]) {
    l[0] = tr_read<v_rd_off(D0, 0, 0)>(vb); h[0] = tr_read<v_rd_off(D0, 0, 1)>(vb); l[1] = tr_read<v_rd_off(D0, 1, 0)>(vb); h[1] = tr_read<v_rd_off(D0, 1, 1)>(vb);
    l[2] = tr_read<v_rd_off(D0, 2, 0)>(vb); h[2] = tr_read<v_rd_off(D0, 2, 1)>(vb); l[3] = tr_read<v_rd_off(D0, 3, 0)>(vb); h[3] = tr_read<v_rd_off(D0, 3, 1)>(vb);
}
__device__ __forceinline__ void pv_mma(f32x16& od, const s16x4 (&l)[4], const s16x4 (&h)[4], bf16x8 pa0, bf16x8 pa1, bf16x8 pa2, bf16x8 pa3) {
    asm volatile("s_waitcnt lgkmcnt(0)" ::: "memory"); SBAR();
#define PK(L, H) (bf16x8){L[0], L[1], L[2], L[3], H[0], H[1], H[2], H[3]}
    od = __builtin_amdgcn_mfma_f32_32x32x16_bf16(pa0, PK(l[0], h[0]), od, 0, 0, 0);
    od = __builtin_amdgcn_mfma_f32_32x32x16_bf16(pa1, PK(l[1], h[1]), od, 0, 0, 0);
    od = __builtin_amdgcn_mfma_f32_32x32x16_bf16(pa2, PK(l[2], h[2]), od, 0, 0, 0);
    od = __builtin_amdgcn_mfma_f32_32x32x16_bf16(pa3, PK(l[3], h[3]), od, 0, 0, 0);
#undef PK
}
__device__ __forceinline__ void pv_sm(f32x16 (&o)[4], int vb, bf16x8 pa0, bf16x8 pa1, bf16x8 pa2, bf16x8 pa3, f32x16& p0, f32x16& p1, float& m_reg, float& alpha) {
    s16x4 l[4], h[4];
    pv_reads<0>(vb, l, h);
    float pmax = p0[0];
#pragma unroll
    for (int r = 1; r < 16; ++r) pmax = fmaxf(pmax, p0[r]);
    pv_mma(o[0], l, h, pa0, pa1, pa2, pa3);
    pv_reads<1>(vb, l, h);
#pragma unroll
    for (int r = 0; r < 16; ++r) pmax = fmaxf(pmax, p1[r]);
    { auto rr = __builtin_amdgcn_permlane32_swap(__float_as_uint(pmax), __float_as_uint(pmax), false, false);
      pmax = fmaxf(__uint_as_float(rr[0]), __uint_as_float(rr[1])); }
    pv_mma(o[1], l, h, pa0, pa1, pa2, pa3);
    pv_reads<2>(vb, l, h);
    float mn;
    if (__builtin_expect(__all(pmax - m_reg <= THR2), 1)) { mn = m_reg; alpha = 1.f; }
    else { mn = fmaxf(m_reg, pmax); alpha = __builtin_amdgcn_exp2f(m_reg - mn); m_reg = mn; }
#pragma unroll
    for (int r = 0; r < 16; ++r) p0[r] = p0[r] - mn;
    pv_mma(o[2], l, h, pa0, pa1, pa2, pa3);
    pv_reads<3>(vb, l, h);
#pragma unroll
    for (int r = 0; r < 16; ++r) p1[r] = p1[r] - mn;
    pv_mma(o[3], l, h, pa0, pa1, pa2, pa3);
#pragma unroll
    for (int r = 0; r < 16; ++r) p0[r] = __builtin_amdgcn_exp2f(p0[r]);
}

__device__ __forceinline__ void attn_unit(int b, int h, int qb, const bf16* Qraw, const bf16* KFp, const bf16* VTp, const bf16* GA, bf16* ATTG,
                                          const float* gq, const float* COS, const float* SIN, LAS unsigned char* lds, const int wid) {
    const int lane = lane_id_opaque(), tid = wid * 64 + lane, r32 = lane & 31, hi = lane >> 5;
    LAS float* wsf = (LAS float*)(lds + L_WS) + wid * 64; LAS float* li_l = wsf; LAS float* al_l = wsf + 32;
    const int tok0 = b * SEQ + qb * 256 + wid * 32;
    bf16x8 qr[12];
    {
        const int tok = tok0 + r32; const bf16* qp = Qraw + (size_t)tok * (NH * DQK) + h * DQK + hi * 8;
        v4u raw[12]; float ss = 0.f;
#pragma unroll
        for (int d0 = 0; d0 < 12; ++d0) { raw[d0] = *(const v4u*)(qp + d0 * 16); float f[8]; unpack8(raw[d0], f);
#pragma unroll
            for (int j = 0; j < 8; ++j) ss += f[j] * f[j]; }
        ss += __shfl_xor(ss, 32);
        const float CQ = 0.07216878364870322f * LOG2E;
        const float rs = (1.0f / sqrtf(ss * (1.f / DQK) + EPS));
#pragma unroll
        for (int d0 = 0; d0 < 8; ++d0) { float f[8]; unpack8(raw[d0], f); const f32x4 g0 = *(const f32x4*)(gq + d0 * 16 + hi * 8), g1 = *(const f32x4*)(gq + d0 * 16 + hi * 8 + 4);
            const float sc = rs * CQ;
            v4u w; w.x = cvtpk(f[0] * sc * g0[0], f[1] * sc * g0[1]); w.y = cvtpk(f[2] * sc * g0[2], f[3] * sc * g0[3]); w.z = cvtpk(f[4] * sc * g1[0], f[5] * sc * g1[1]); w.w = cvtpk(f[6] * sc * g1[2], f[7] * sc * g1[3]);
            qr[d0] = __builtin_bit_cast(bf16x8, w); }
#pragma unroll
        for (int e = 0; e < 2; ++e) {
            float f1[8], f2[8]; unpack8(raw[8 + e], f1); unpack8(raw[10 + e], f2);
            float o1[8], o2[8];
#pragma unroll
            for (int j = 0; j < 8; ++j) { const int i = 16 * e + 8 * hi + j; const float c = COS[(size_t)tok * 32 + i], s = SIN[(size_t)tok * 32 + i];
                const float v1 = f1[j] * rs * gq[DNOPE + i], v2 = f2[j] * rs * gq[DNOPE + 32 + i];
                o1[j] = (v1 * c - v2 * s) * CQ; o2[j] = (v2 * c + v1 * s) * CQ; }
            v4u w; w.x = cvtpk(o1[0], o1[1]); w.y = cvtpk(o1[2], o1[3]); w.z = cvtpk(o1[4], o1[5]); w.w = cvtpk(o1[6], o1[7]); qr[8 + e] = __builtin_bit_cast(bf16x8, w);
            v4u x; x.x = cvtpk(o2[0], o2[1]); x.y = cvtpk(o2[2], o2[3]); x.z = cvtpk(o2[4], o2[5]); x.w = cvtpk(o2[6], o2[7]); qr[10 + e] = __builtin_bit_cast(bf16x8, x);
        }
    }
    float m_reg = -1e30f, l_reg = 0.f; f32x16 o[4] = {};
    const unsigned char* Kg = (const unsigned char*)(KFp + (size_t)((b * NH + h) * 32) * 12288) + lane * 16;
    const unsigned char* Vg = (const unsigned char*)VTp + (size_t)((b * NH + h) * 32) * 16384 + lane * 16;
    LAS unsigned char* K_lds = lds + L_K; LAS unsigned char* V_lds = lds + L_V;
    const int vb0 = (int)(uintptr_t)V_lds + v_rd_base(lane);
#define DMA_K(t, slot) do { _Pragma("unroll") for (int i_ = 0; i_ < 3; ++i_) __builtin_amdgcn_global_load_lds((const unsigned*)(Kg + (size_t)(t) * KT_BYTES + (wid + 8 * i_) * 1024), \
        (LAS unsigned*)(K_lds + (slot) * KT_BYTES + (wid + 8 * i_) * 1024), 16, 0, 0); } while (0)
#define DMA_V(t, slot) do { _Pragma("unroll") for (int i_ = 0; i_ < 2; ++i_) __builtin_amdgcn_global_load_lds((const unsigned*)(Vg + (size_t)(t) * VT_BYTES + (wid + 8 * i_) * 1024), \
        (LAS unsigned*)(V_lds + (slot) * VT_BYTES + (wid + 8 * i_) * 1024), 16, 0, 0); } while (0)
#define WAIT_BAR(N) asm volatile("s_waitcnt vmcnt(" #N ")\n\ts_barrier" ::: "memory")
#define RESC(a) do { if (__any((a) < 1.f)) { if (hi == 0) al_l[r32] = (a); asm volatile("s_waitcnt lgkmcnt(0)" ::: "memory"); \
    _Pragma("unroll") for (int d = 0; d < 4; ++d) _Pragma("unroll") for (int r = 0; r < 16; ++r) o[d][r] *= al_l[crow(r, hi)]; } } while (0)
    f32x16 pA0, pA1, pB0, pB1; float alA, alB; bf16x8 pa0, pa1, pa2, pa3; constexpr int NT = SEQ / 64;
    DMA_K(0, 0); DMA_V(0, 0); DMA_K(1, 1);
    WAIT_BAR(0);
    DMA_K(2, 2); DMA_V(1, 1);
    qkt(pA0, pA1, K_lds, qr, r32, hi); partialSM(pA0, pA1, m_reg, alA);
    WAIT_BAR(5);
    int sk = 1, sv = 0;
#define NEXT3(x) ((x) == 2 ? 0 : (x) + 1)
#define PREV3(x) ((x) == 0 ? 2 : (x) - 1)
    for (int j = 1; j + 1 < NT; j += 2) {
        DMA_K(j + 2, PREV3(sk)); DMA_V(j + 1, NEXT3(sk));
        SBAR(); qkt(pB0, pB1, K_lds + sk * KT_BYTES, qr, r32, hi);
        finishSM(pA0, pA1, alA, l_reg, pa0, pa1, pa2, pa3); SBAR();
        pv_sm(o, vb0 + sv * VT_BYTES, pa0, pa1, pa2, pa3, pB0, pB1, m_reg, alB);
        RESC(alB);
        WAIT_BAR(5);
        sk = NEXT3(sk); sv = NEXT3(sv);
        const bool more = (j + 3 < NT);
        if (more) DMA_K(j + 3, PREV3(sk));
        DMA_V(j + 2, NEXT3(sk));
        SBAR(); qkt(pA0, pA1, K_lds + sk * KT_BYTES, qr, r32, hi);
        finishSM(pB0, pB1, alB, l_reg, pa0, pa1, pa2, pa3); SBAR();
        pv_sm(o, vb0 + sv * VT_BYTES, pa0, pa1, pa2, pa3, pA0, pA1, m_reg, alA);
        RESC(alA);
        if (more) WAIT_BAR(5); else WAIT_BAR(2);
        sk = NEXT3(sk); sv = NEXT3(sv);
    }
    SBAR(); qkt(pB0, pB1, K_lds + sk * KT_BYTES, qr, r32, hi);
    finishSM(pA0, pA1, alA, l_reg, pa0, pa1, pa2, pa3); SBAR();
    pv_sm(o, vb0 + sv * VT_BYTES, pa0, pa1, pa2, pa3, pB0, pB1, m_reg, alB);
    RESC(alB);
    WAIT_BAR(0);
    sv = NEXT3(sv);
    finishSM(pB0, pB1, alB, l_reg, pa0, pa1, pa2, pa3); SBAR();
    pv_d0(o, vb0 + sv * VT_BYTES, pa0, pa1, pa2, pa3);
    if (hi == 0) li_l[r32] = l_reg; asm volatile("s_waitcnt lgkmcnt(0)" ::: "memory");
    { unsigned short gv[16][4];
#pragma unroll
      for (int r = 0; r < 16; ++r) { const size_t ro = (size_t)(tok0 + crow(r, hi)) * 2048 + h * DV + r32;
#pragma unroll
          for (int d0 = 0; d0 < 4; ++d0) gv[r][d0] = GA[ro + d0 * 32]; }
#pragma unroll
      for (int r = 0; r < 16; ++r) { const int orow = crow(r, hi); const float rl = __builtin_amdgcn_rcpf(li_l[orow]); const size_t wo = (size_t)(tok0 + orow) * ACAT_LD + CW + h * DV + r32;
#pragma unroll
          for (int d0 = 0; d0 < 4; ++d0) { const float g = bflo((unsigned)gv[r][d0]); ATTG[wo + d0 * 32] = (bf16)f2bf(o[d0][r] * rl * siluf_(g)); } } }
    __syncthreads();
#undef DMA_K
#undef DMA_V
#undef WAIT_BAR
#undef NEXT3
#undef PREV3
#undef RESC
}

typedef int i32x8 __attribute__((ext_vector_type(8)));
constexpr int K8_BYTES = 12288, K8_SLOT = 16384;
constexpr int L8_K = 0, L8_V = NSLOT * K8_SLOT, L8_WS = L8_V + NSLOT * VT_BYTES, L8_END = L8_WS + NWAVES * 256;
constexpr float CQ8 = 0.07216878364870322f * LOG2E;
__device__ __forceinline__ void qkt8(f32x16& p0, f32x16& p1, const LAS unsigned char* Ks, const i32x8 (&qf)[3], int r32, int hi) {
    p0 = f32x16{}; p1 = f32x16{};
#pragma unroll
    for (int s = 0; s < 3; ++s) { const LAS unsigned char* c0 = Ks + ((s * 2 + hi) * 2) * 1024 + r32 * 16;
        const v4u a0l = *(const LAS v4u*)(c0), a0h = *(const LAS v4u*)(c0 + 1024), a1l = *(const LAS v4u*)(c0 + 512), a1h = *(const LAS v4u*)(c0 + 1024 + 512);
        const i32x8 a0 = {(int)a0l.x, (int)a0l.y, (int)a0l.z, (int)a0l.w, (int)a0h.x, (int)a0h.y, (int)a0h.z, (int)a0h.w};
        const i32x8 a1 = {(int)a1l.x, (int)a1l.y, (int)a1l.z, (int)a1l.w, (int)a1h.x, (int)a1h.y, (int)a1h.z, (int)a1h.w};
        p0 = __builtin_amdgcn_mfma_scale_f32_32x32x64_f8f6f4(a0, qf[s], p0, 0, 0, 0, 0x7F7F7F7F, 0, 0x7F7F7F7F);
        p1 = __builtin_amdgcn_mfma_scale_f32_32x32x64_f8f6f4(a1, qf[s], p1, 0, 0, 0, 0x7F7F7F7F, 0, 0x7F7F7F7F); }
}
__device__ __forceinline__ void partialSM8(f32x16& p0, f32x16& p1, float& m_reg, float& alpha) {
    float pmax = p0[0];
#pragma unroll
    for (int r = 1; r < 16; ++r) pmax = fmaxf(pmax, p0[r]);
#pragma unroll
    for (int r = 0; r < 16; ++r) pmax = fmaxf(pmax, p1[r]);
    { auto rr = __builtin_amdgcn_permlane32_swap(__float_as_uint(pmax), __float_as_uint(pmax), false, false);
      pmax = fmaxf(__uint_as_float(rr[0]), __uint_as_float(rr[1])); }
    float mn;
    if (__builtin_expect(__all((pmax - m_reg) * CQ8 <= THR2), 1)) { mn = m_reg; alpha = 1.f; }
    else { mn = fmaxf(m_reg, pmax); alpha = __builtin_amdgcn_exp2f((m_reg - mn) * CQ8); m_reg = mn; }
    const float mnC = -mn * CQ8;
#pragma unroll
    for (int r = 0; r < 16; ++r) p0[r] = fmaf(p0[r], CQ8, mnC);
#pragma unroll
    for (int r = 0; r < 16; ++r) p1[r] = fmaf(p1[r], CQ8, mnC);
#pragma unroll
    for (int r = 0; r < 16; ++r) p0[r] = __builtin_amdgcn_exp2f(p0[r]);
}
__device__ __forceinline__ void pv_sm8(f32x16 (&o)[4], int vb, bf16x8 pa0, bf16x8 pa1, bf16x8 pa2, bf16x8 pa3, f32x16& p0, f32x16& p1, float& m_reg, float& alpha) {
    s16x4 l[4], h[4];
    pv_reads<0>(vb, l, h);
    float pmax = p0[0];
#pragma unroll
    for (int r = 1; r < 16; ++r) pmax = fmaxf(pmax, p0[r]);
    pv_mma(o[0], l, h, pa0, pa1, pa2, pa3);
    pv_reads<1>(vb, l, h);
#pragma unroll
    for (int r = 0; r < 16; ++r) pmax = fmaxf(pmax, p1[r]);
    { auto rr = __builtin_amdgcn_permlane32_swap(__float_as_uint(pmax), __float_as_uint(pmax), false, false);
      pmax = fmaxf(__uint_as_float(rr[0]), __uint_as_float(rr[1])); }
    pv_mma(o[1], l, h, pa0, pa1, pa2, pa3);
    pv_reads<2>(vb, l, h);
    float mn;
    if (__builtin_expect(__all((pmax - m_reg) * CQ8 <= THR2), 1)) { mn = m_reg; alpha = 1.f; }
    else { mn = fmaxf(m_reg, pmax); alpha = __builtin_amdgcn_exp2f((m_reg - mn) * CQ8); m_reg = mn; }
    const float mnC = -mn * CQ8;
#pragma unroll
    for (int r = 0; r < 16; ++r) p0[r] = fmaf(p0[r], CQ8, mnC);
    pv_mma(o[2], l, h, pa0, pa1, pa2, pa3);
    pv_reads<3>(vb, l, h);
#pragma unroll
    for (int r = 0; r < 16; ++r) p1[r] = fmaf(p1[r], CQ8, mnC);
    pv_mma(o[3], l, h, pa0, pa1, pa2, pa3);
#pragma unroll
    for (int r = 0; r < 16; ++r) p0[r] = __builtin_amdgcn_exp2f(p0[r]);
}
template <bool CHECK>
__device__ __forceinline__ void attn_unit8(int b, int h, int qb, const bf16* Qraw, const unsigned char* KF8, const bf16* VTp, const bf16* GA, bf16* ATTG,
                                           const float* gq, const float* COS, const float* SIN, LAS unsigned char* lds, const int wid, float* chk) {
    const int lane = lane_id_opaque(), r32 = lane & 31, hi = lane >> 5;
    LAS float* wsf = (LAS float*)(lds + L8_WS) + wid * 64; LAS float* li_l = wsf; LAS float* al_l = wsf + 32;
    const int tok0 = b * SEQ + qb * 256 + wid * 32;
    i32x8 qf[3];
    {
        const int tok = tok0 + r32; const bf16* qp = Qraw + (size_t)tok * (NH * DQK) + h * DQK;
        v4u raw[12]; float ss = 0.f;
#pragma unroll
        for (int c = 0; c < 4; ++c) { raw[c] = *(const v4u*)(qp + 32 * hi + 8 * c); raw[4 + c] = *(const v4u*)(qp + 64 + 32 * hi + 8 * c); }
#pragma unroll
        for (int c = 0; c < 2; ++c) { raw[8 + c] = *(const v4u*)(qp + 128 + 16 * hi + 8 * c); raw[10 + c] = *(const v4u*)(qp + 160 + 16 * hi + 8 * c); }
#pragma unroll
        for (int c = 0; c < 12; ++c) { float f[8]; unpack8(raw[c], f);
#pragma unroll
            for (int j = 0; j < 8; ++j) ss += f[j] * f[j]; }
        ss += __shfl_xor(ss, 32);
        const float rs = (1.0f / sqrtf(ss * (1.f / DQK) + EPS));
#pragma unroll
        for (int s2 = 0; s2 < 2; ++s2)
#pragma unroll
            for (int c = 0; c < 4; ++c) { float f[8]; unpack8(raw[4 * s2 + c], f); const float* gp = gq + 64 * s2 + 32 * hi + 8 * c; const f32x4 g0 = *(const f32x4*)gp, g1 = *(const f32x4*)(gp + 4);
                qf[s2][2 * c] = (int)pack4_fp8(f[0] * rs * g0[0], f[1] * rs * g0[1], f[2] * rs * g0[2], f[3] * rs * g0[3]);
                qf[s2][2 * c + 1] = (int)pack4_fp8(f[4] * rs * g1[0], f[5] * rs * g1[1], f[6] * rs * g1[2], f[7] * rs * g1[3]); }
#pragma unroll
        for (int c = 0; c < 2; ++c) { float f1[8], f2[8], o1[8], o2[8]; unpack8(raw[8 + c], f1); unpack8(raw[10 + c], f2);
#pragma unroll
            for (int j = 0; j < 8; ++j) { const int i = 16 * hi + 8 * c + j; const float cs = COS[(size_t)tok * 32 + i], sn = SIN[(size_t)tok * 32 + i];
                const float v1 = f1[j] * rs * gq[DNOPE + i], v2 = f2[j] * rs * gq[DNOPE + 32 + i];
                o1[j] = v1 * cs - v2 * sn; o2[j] = v2 * cs + v1 * sn; }
            qf[2][2 * c] = (int)pack4_fp8(o1[0], o1[1], o1[2], o1[3]); qf[2][2 * c + 1] = (int)pack4_fp8(o1[4], o1[5], o1[6], o1[7]);
            qf[2][4 + 2 * c] = (int)pack4_fp8(o2[0], o2[1], o2[2], o2[3]); qf[2][4 + 2 * c + 1] = (int)pack4_fp8(o2[4], o2[5], o2[6], o2[7]); }
    }
    float m_reg = -1e30f, l_reg = 0.f; f32x16 o[4] = {};
    const unsigned char* Kg = KF8 + (size_t)(((b & 1) * NH + h) * 32) * K8_BYTES + lane * 16;
    const unsigned char* Vg = (const unsigned char*)VTp + (size_t)((b * NH + h) * 32) * 16384 + lane * 16;
    LAS unsigned char* K_lds = lds + L8_K; LAS unsigned char* V_lds = lds + L8_V;
    const int vb0 = (int)(uintptr_t)V_lds + v_rd_base(lane);
    const int kp1 = (wid + 8 < 12) ? wid + 8 : wid + 4;
#define DMA_K(t, slot) do { __builtin_amdgcn_global_load_lds((const unsigned*)(Kg + (size_t)(t) * K8_BYTES + wid * 1024), (LAS unsigned*)(K_lds + (slot) * K8_SLOT + wid * 1024), 16, 0, 0); \
        __builtin_amdgcn_global_load_lds((const unsigned*)(Kg + (size_t)(t) * K8_BYTES + kp1 * 1024), (LAS unsigned*)(K_lds + (slot) * K8_SLOT + (wid + 8) * 1024), 16, 0, 0); } while (0)
#define DMA_V(t, slot) do { _Pragma("unroll") for (int i_ = 0; i_ < 2; ++i_) __builtin_amdgcn_global_load_lds((const unsigned*)(Vg + (size_t)(t) * VT_BYTES + (wid + 8 * i_) * 1024), \
        (LAS unsigned*)(V_lds + (slot) * VT_BYTES + (wid + 8 * i_) * 1024), 16, 0, 0); } while (0)
#define WAIT_BAR(N) asm volatile("s_waitcnt vmcnt(" #N ")\n\ts_barrier" ::: "memory")
#define RESC(a) do { if (__any((a) < 1.f)) { if (hi == 0) al_l[r32] = (a); asm volatile("s_waitcnt lgkmcnt(0)" ::: "memory"); \
    _Pragma("unroll") for (int d = 0; d < 4; ++d) _Pragma("unroll") for (int r = 0; r < 16; ++r) o[d][r] *= al_l[crow(r, hi)]; } } while (0)
    f32x16 pA0, pA1, pB0, pB1; float alA, alB; bf16x8 pa0, pa1, pa2, pa3; constexpr int NT = SEQ / 64;
    DMA_K(0, 0); DMA_V(0, 0); DMA_K(1, 1);
    WAIT_BAR(0);
    DMA_K(2, 2); DMA_V(1, 1);
    qkt8(pA0, pA1, K_lds, qf, r32, hi); partialSM8(pA0, pA1, m_reg, alA);
    WAIT_BAR(4);
    int sk = 1, sv = 0;
#define NEXT3(x) ((x) == 2 ? 0 : (x) + 1)
#define PREV3(x) ((x) == 0 ? 2 : (x) - 1)
    for (int j = 1; j + 1 < NT; j += 2) {
        DMA_K(j + 2, PREV3(sk)); DMA_V(j + 1, NEXT3(sk));
        SBAR(); qkt8(pB0, pB1, K_lds + sk * K8_SLOT, qf, r32, hi);
        finishSM(pA0, pA1, alA, l_reg, pa0, pa1, pa2, pa3); SBAR();
        pv_sm8(o, vb0 + sv * VT_BYTES, pa0, pa1, pa2, pa3, pB0, pB1, m_reg, alB);
        RESC(alB);
        WAIT_BAR(4);
        sk = NEXT3(sk); sv = NEXT3(sv);
        const bool more = (j + 3 < NT);
        if (more) DMA_K(j + 3, PREV3(sk));
        DMA_V(j + 2, NEXT3(sk));
        SBAR(); qkt8(pA0, pA1, K_lds + sk * K8_SLOT, qf, r32, hi);
        finishSM(pB0, pB1, alB, l_reg, pa0, pa1, pa2, pa3); SBAR();
        pv_sm8(o, vb0 + sv * VT_BYTES, pa0, pa1, pa2, pa3, pA0, pA1, m_reg, alA);
        RESC(alA);
        if (more) WAIT_BAR(4); else WAIT_BAR(2);
        sk = NEXT3(sk); sv = NEXT3(sv);
    }
    SBAR(); qkt8(pB0, pB1, K_lds + sk * K8_SLOT, qf, r32, hi);
    finishSM(pA0, pA1, alA, l_reg, pa0, pa1, pa2, pa3); SBAR();
    pv_sm8(o, vb0 + sv * VT_BYTES, pa0, pa1, pa2, pa3, pB0, pB1, m_reg, alB);
    RESC(alB);
    WAIT_BAR(0);
    sv = NEXT3(sv);
    finishSM(pB0, pB1, alB, l_reg, pa0, pa1, pa2, pa3); SBAR();
    pv_d0(o, vb0 + sv * VT_BYTES, pa0, pa1, pa2, pa3);
    if (hi == 0) li_l[r32] = l_reg; asm volatile("s_waitcnt lgkmcnt(0)" ::: "memory");
    { unsigned short gv[16][4];
#pragma unroll
      for (int r = 0; r < 16; ++r) { const size_t ro = (size_t)(tok0 + crow(r, hi)) * 2048 + h * DV + r32;
#pragma unroll
          for (int d0 = 0; d0 < 4; ++d0) gv[r][d0] = GA[ro + d0 * 32]; }
      float dsum = 0.f, rsum = 0.f;
#pragma unroll
      for (int r = 0; r < 16; ++r) { const int orow = crow(r, hi); const float rl = __builtin_amdgcn_rcpf(li_l[orow]); const size_t wo = (size_t)(tok0 + orow) * ACAT_LD + CW + h * DV + r32;
#pragma unroll
          for (int d0 = 0; d0 < 4; ++d0) { const float g = bflo((unsigned)gv[r][d0]); const unsigned vb = f2bf(o[d0][r] * rl * siluf_(g));
              if (CHECK) { const float ref = bflo((unsigned)ATTG[wo + d0 * 32]), val = bflo(vb); dsum += (val - ref) * (val - ref); rsum += ref * ref; }
              else ATTG[wo + d0 * 32] = (bf16)vb; } }
      if (CHECK) { dsum = wave_sum(dsum); rsum = wave_sum(rsum); if (lane == 0) { atomicAdd(chk, dsum); atomicAdd(chk + 1, rsum); } } }
    WAIT_BAR(0);
#undef DMA_K
#undef DMA_V
#undef WAIT_BAR
#undef NEXT3
#undef PREV3
#undef RESC
}

constexpr int V8_BYTES = 8192;
constexpr int L88_K = 0, L88_V = NSLOT * K8_SLOT, L88_WS = L88_V + NSLOT * V8_BYTES, L88_END = L88_WS + NWAVES * 256;
constexpr float THR2_8 = 5.5f * LOG2E;
__device__ __forceinline__ void finishSM88(f32x16& p0, f32x16& p1, float alpha, float& l_reg, i32x8& pa) {
#pragma unroll
    for (int r = 0; r < 16; ++r) p1[r] = __builtin_amdgcn_exp2f(p1[r]);
    float ps = 0;
#pragma unroll
    for (int r = 0; r < 16; ++r) ps += p0[r];
#pragma unroll
    for (int r = 0; r < 16; ++r) ps += p1[r];
    { auto rr = __builtin_amdgcn_permlane32_swap(__float_as_uint(ps), __float_as_uint(ps), false, false);
      ps = __uint_as_float(rr[0]) + __uint_as_float(rr[1]); }
    l_reg = l_reg * alpha + ps;
#pragma unroll
    for (int w = 0; w < 4; ++w) { pa[w] = (int)pack4_fp8(p0[4 * w], p0[4 * w + 1], p0[4 * w + 2], p0[4 * w + 3]); pa[4 + w] = (int)pack4_fp8(p1[4 * w], p1[4 * w + 1], p1[4 * w + 2], p1[4 * w + 3]); }
}
__device__ __forceinline__ i32x8 v8_frag(const LAS unsigned char* Vs, int b4, int r32, int hi) {
    const LAS unsigned char* c0 = Vs + ((b4 * 2 + hi) * 2) * 512 + r32 * 16; const v4u lo = *(const LAS v4u*)c0, hh = *(const LAS v4u*)(c0 + 512);
    return (i32x8){(int)lo.x, (int)lo.y, (int)lo.z, (int)lo.w, (int)hh.x, (int)hh.y, (int)hh.z, (int)hh.w};
}
#define MFMA8(A, B, C) __builtin_amdgcn_mfma_scale_f32_32x32x64_f8f6f4(A, B, C, 0, 0, 0, 0x7F7F7F7F, 0, 0x7F7F7F7F)
__device__ __forceinline__ void pv88(f32x16 (&o)[4], const LAS unsigned char* Vs, const i32x8& pa, int r32, int hi) {
#pragma unroll
    for (int b4 = 0; b4 < 4; ++b4) o[b4] = MFMA8(pa, v8_frag(Vs, b4, r32, hi), o[b4]);
}
__device__ __forceinline__ void pv_sm88(f32x16 (&o)[4], const LAS unsigned char* Vs, const i32x8& pa, int r32, int hi, f32x16& p0, f32x16& p1, float& m_reg, float& alpha) {
    i32x8 vf = v8_frag(Vs, 0, r32, hi);
    float pmax = p0[0];
#pragma unroll
    for (int r = 1; r < 16; ++r) pmax = fmaxf(pmax, p0[r]);
    o[0] = MFMA8(pa, vf, o[0]);
    vf = v8_frag(Vs, 1, r32, hi);
#pragma unroll
    for (int r = 0; r < 16; ++r) pmax = fmaxf(pmax, p1[r]);
    { auto rr = __builtin_amdgcn_permlane32_swap(__float_as_uint(pmax), __float_as_uint(pmax), false, false);
      pmax = fmaxf(__uint_as_float(rr[0]), __uint_as_float(rr[1])); }
    o[1] = MFMA8(pa, vf, o[1]);
    vf = v8_frag(Vs, 2, r32, hi);
    float mn;
    if (__builtin_expect(__all((pmax - m_reg) * CQ8 <= THR2_8), 1)) { mn = m_reg; alpha = 1.f; }
    else { mn = fmaxf(m_reg, pmax); alpha = __builtin_amdgcn_exp2f((m_reg - mn) * CQ8); m_reg = mn; }
    const float mnC = -mn * CQ8;
#pragma unroll
    for (int r = 0; r < 16; ++r) p0[r] = fmaf(p0[r], CQ8, mnC);
    o[2] = MFMA8(pa, vf, o[2]);
    vf = v8_frag(Vs, 3, r32, hi);
#pragma unroll
    for (int r = 0; r < 16; ++r) p1[r] = fmaf(p1[r], CQ8, mnC);
    o[3] = MFMA8(pa, vf, o[3]);
#pragma unroll
    for (int r = 0; r < 16; ++r) p0[r] = __builtin_amdgcn_exp2f(p0[r]);
}
__device__ __forceinline__ void partialSM88(f32x16& p0, f32x16& p1, float& m_reg, float& alpha) {
    float pmax = p0[0];
#pragma unroll
    for (int r = 1; r < 16; ++r) pmax = fmaxf(pmax, p0[r]);
#pragma unroll
    for (int r = 0; r < 16; ++r) pmax = fmaxf(pmax, p1[r]);
    { auto rr = __builtin_amdgcn_permlane32_swap(__float_as_uint(pmax), __float_as_uint(pmax), false, false);
      pmax = fmaxf(__uint_as_float(rr[0]), __uint_as_float(rr[1])); }
    float mn;
    if (__builtin_expect(__all((pmax - m_reg) * CQ8 <= THR2_8), 1)) { mn = m_reg; alpha = 1.f; }
    else { mn = fmaxf(m_reg, pmax); alpha = __builtin_amdgcn_exp2f((m_reg - mn) * CQ8); m_reg = mn; }
    const float mnC = -mn * CQ8;
#pragma unroll
    for (int r = 0; r < 16; ++r) p0[r] = fmaf(p0[r], CQ8, mnC);
#pragma unroll
    for (int r = 0; r < 16; ++r) p1[r] = fmaf(p1[r], CQ8, mnC);
#pragma unroll
    for (int r = 0; r < 16; ++r) p0[r] = __builtin_amdgcn_exp2f(p0[r]);
}
__device__ __forceinline__ void attn_unit88(int b, int h, int qb, const bf16* Qraw, const unsigned char* KF8, const unsigned char* V8, const bf16* GA, bf16* ATTG,
                                            const float* gq, const float* COS, const float* SIN, LAS unsigned char* lds, const int wid) {
    const int lane = lane_id_opaque(), r32 = lane & 31, hi = lane >> 5;
    LAS float* wsf = (LAS float*)(lds + L88_WS) + wid * 64; LAS float* li_l = wsf; LAS float* al_l = wsf + 32;
    const int tok0 = b * SEQ + qb * 256 + wid * 32;
    i32x8 qf[3];
    {
        const int tok = tok0 + r32; const bf16* qp = Qraw + (size_t)tok * (NH * DQK) + h * DQK;
        v4u raw[12]; float ss = 0.f;
#pragma unroll
        for (int c = 0; c < 4; ++c) { raw[c] = *(const v4u*)(qp + 32 * hi + 8 * c); raw[4 + c] = *(const v4u*)(qp + 64 + 32 * hi + 8 * c); }
#pragma unroll
        for (int c = 0; c < 2; ++c) { raw[8 + c] = *(const v4u*)(qp + 128 + 16 * hi + 8 * c); raw[10 + c] = *(const v4u*)(qp + 160 + 16 * hi + 8 * c); }
#pragma unroll
        for (int c = 0; c < 12; ++c) { float f[8]; unpack8(raw[c], f);
#pragma unroll
            for (int j = 0; j < 8; ++j) ss += f[j] * f[j]; }
        ss += __shfl_xor(ss, 32);
        const float rs = (1.0f / sqrtf(ss * (1.f / DQK) + EPS));
#pragma unroll
        for (int s2 = 0; s2 < 2; ++s2)
#pragma unroll
            for (int c = 0; c < 4; ++c) { float f[8]; unpack8(raw[4 * s2 + c], f); const float* gp = gq + 64 * s2 + 32 * hi + 8 * c; const f32x4 g0 = *(const f32x4*)gp, g1 = *(const f32x4*)(gp + 4);
                qf[s2][2 * c] = (int)pack4_fp8(f[0] * rs * g0[0], f[1] * rs * g0[1], f[2] * rs * g0[2], f[3] * rs * g0[3]);
                qf[s2][2 * c + 1] = (int)pack4_fp8(f[4] * rs * g1[0], f[5] * rs * g1[1], f[6] * rs * g1[2], f[7] * rs * g1[3]); }
#pragma unroll
        for (int c = 0; c < 2; ++c) { float f1[8], f2[8], o1[8], o2[8]; unpack8(raw[8 + c], f1); unpack8(raw[10 + c], f2);
#pragma unroll
            for (int j = 0; j < 8; ++j) { const int i = 16 * hi + 8 * c + j; const float cs = COS[(size_t)tok * 32 + i], sn = SIN[(size_t)tok * 32 + i];
                const float v1 = f1[j] * rs * gq[DNOPE + i], v2 = f2[j] * rs * gq[DNOPE + 32 + i];
                o1[j] = v1 * cs - v2 * sn; o2[j] = v2 * cs + v1 * sn; }
            qf[2][2 * c] = (int)pack4_fp8(o1[0], o1[1], o1[2], o1[3]); qf[2][2 * c + 1] = (int)pack4_fp8(o1[4], o1[5], o1[6], o1[7]);
            qf[2][4 + 2 * c] = (int)pack4_fp8(o2[0], o2[1], o2[2], o2[3]); qf[2][4 + 2 * c + 1] = (int)pack4_fp8(o2[4], o2[5], o2[6], o2[7]); }
    }
    float m_reg = -1e30f, l_reg = 0.f; f32x16 o[4] = {};
    const unsigned char* Kg = KF8 + (size_t)(((b & 1) * NH + h) * 32) * K8_BYTES + lane * 16;
    const unsigned char* Vg = V8 + (size_t)((b * NH + h) * 32) * V8_BYTES + lane * 16;
    LAS unsigned char* K_lds = lds + L88_K; LAS unsigned char* V_lds = lds + L88_V;
    const int kp1 = (wid + 8 < 12) ? wid + 8 : wid + 4;
#define DMA_K(t, slot) do { __builtin_amdgcn_global_load_lds((const unsigned*)(Kg + (size_t)(t) * K8_BYTES + wid * 1024), (LAS unsigned*)(K_lds + (slot) * K8_SLOT + wid * 1024), 16, 0, 0); \
        __builtin_amdgcn_global_load_lds((const unsigned*)(Kg + (size_t)(t) * K8_BYTES + kp1 * 1024), (LAS unsigned*)(K_lds + (slot) * K8_SLOT + (wid + 8) * 1024), 16, 0, 0); } while (0)
#define DMA_V(t, slot) __builtin_amdgcn_global_load_lds((const unsigned*)(Vg + (size_t)(t) * V8_BYTES + wid * 1024), (LAS unsigned*)(V_lds + (slot) * V8_BYTES + wid * 1024), 16, 0, 0)
#define WAIT_BAR(N) asm volatile("s_waitcnt vmcnt(" #N ")\n\ts_barrier" ::: "memory")
#define RESC(a) do { if (__any((a) < 1.f)) { if (hi == 0) al_l[r32] = (a); asm volatile("s_waitcnt lgkmcnt(0)" ::: "memory"); \
    _Pragma("unroll") for (int d = 0; d < 4; ++d) _Pragma("unroll") for (int r = 0; r < 16; ++r) o[d][r] *= al_l[crow(r, hi)]; } } while (0)
    f32x16 pA0, pA1, pB0, pB1; float alA, alB; i32x8 pa; constexpr int NT = SEQ / 64;
    DMA_K(0, 0); DMA_V(0, 0); DMA_K(1, 1);
    WAIT_BAR(0);
    DMA_K(2, 2); DMA_V(1, 1);
    qkt8(pA0, pA1, K_lds, qf, r32, hi); partialSM88(pA0, pA1, m_reg, alA);
    WAIT_BAR(3);
    int sk = 1, sv = 0;
#define NEXT3(x) ((x) == 2 ? 0 : (x) + 1)
#define PREV3(x) ((x) == 0 ? 2 : (x) - 1)
    for (int j = 1; j + 1 < NT; j += 2) {
        DMA_K(j + 2, PREV3(sk)); DMA_V(j + 1, NEXT3(sk));
        SBAR(); qkt8(pB0, pB1, K_lds + sk * K8_SLOT, qf, r32, hi);
        finishSM88(pA0, pA1, alA, l_reg, pa); SBAR();
        pv_sm88(o, V_lds + sv * V8_BYTES, pa, r32, hi, pB0, pB1, m_reg, alB);
        RESC(alB);
        WAIT_BAR(3);
        sk = NEXT3(sk); sv = NEXT3(sv);
        const bool more = (j + 3 < NT);
        if (more) DMA_K(j + 3, PREV3(sk));
        DMA_V(j + 2, NEXT3(sk));
        SBAR(); qkt8(pA0, pA1, K_lds + sk * K8_SLOT, qf, r32, hi);
        finishSM88(pB0, pB1, alB, l_reg, pa); SBAR();
        pv_sm88(o, V_lds + sv * V8_BYTES, pa, r32, hi, pA0, pA1, m_reg, alA);
        RESC(alA);
        if (more) WAIT_BAR(3); else WAIT_BAR(1);
        sk = NEXT3(sk); sv = NEXT3(sv);
    }
    SBAR(); qkt8(pB0, pB1, K_lds + sk * K8_SLOT, qf, r32, hi);
    finishSM88(pA0, pA1, alA, l_reg, pa); SBAR();
    pv_sm88(o, V_lds + sv * V8_BYTES, pa, r32, hi, pB0, pB1, m_reg, alB);
    RESC(alB);
    WAIT_BAR(0);
    sv = NEXT3(sv);
    finishSM88(pB0, pB1, alB, l_reg, pa); SBAR();
    pv88(o, V_lds + sv * V8_BYTES, pa, r32, hi);
    if (hi == 0) li_l[r32] = l_reg; asm volatile("s_waitcnt lgkmcnt(0)" ::: "memory");
    { unsigned short gv[16][4];
#pragma unroll
      for (int r = 0; r < 16; ++r) { const size_t ro = (size_t)(tok0 + crow(r, hi)) * 2048 + h * DV + r32;
#pragma unroll
          for (int d0 = 0; d0 < 4; ++d0) gv[r][d0] = GA[ro + d0 * 32]; }
#pragma unroll
      for (int r = 0; r < 16; ++r) { const int orow = crow(r, hi); const float rl = __builtin_amdgcn_rcpf(li_l[orow]); const size_t wo = (size_t)(tok0 + orow) * ACAT_LD + CW + h * DV + r32;
#pragma unroll
          for (int d0 = 0; d0 < 4; ++d0) { const float g = bflo((unsigned)gv[r][d0]); ATTG[wo + d0 * 32] = (bf16)f2bf(o[d0][r] * rl * siluf_(g)); } } }
    WAIT_BAR(0);
#undef DMA_K
#undef DMA_V
#undef WAIT_BAR
#undef NEXT3
#undef PREV3
#undef RESC
}

__device__ __forceinline__ void qkt8n(f32x16& p0, f32x16& p1, const LAS unsigned char* Ks, const i32x8 (&qf)[3], const f32x16& negm, int r32, int hi) {
#pragma unroll
    for (int s = 0; s < 3; ++s) { const LAS unsigned char* c0 = Ks + ((s * 2 + hi) * 2) * 1024 + r32 * 16;
        const v4u a0l = *(const LAS v4u*)(c0), a0h = *(const LAS v4u*)(c0 + 1024), a1l = *(const LAS v4u*)(c0 + 512), a1h = *(const LAS v4u*)(c0 + 1024 + 512);
        const i32x8 a0 = {(int)a0l.x, (int)a0l.y, (int)a0l.z, (int)a0l.w, (int)a0h.x, (int)a0h.y, (int)a0h.z, (int)a0h.w};
        const i32x8 a1 = {(int)a1l.x, (int)a1l.y, (int)a1l.z, (int)a1l.w, (int)a1h.x, (int)a1h.y, (int)a1h.z, (int)a1h.w};
        if (s == 0) { p0 = MFMA8(a0, qf[s], negm); p1 = MFMA8(a1, qf[s], negm); } else { p0 = MFMA8(a0, qf[s], p0); p1 = MFMA8(a1, qf[s], p1); } }
}
__device__ __forceinline__ float rowmax32(const f32x16& p0, const f32x16& p1) {
    float pmax = p0[0];
#pragma unroll
    for (int r = 1; r < 16; ++r) pmax = fmaxf(pmax, p0[r]);
#pragma unroll
    for (int r = 0; r < 16; ++r) pmax = fmaxf(pmax, p1[r]);
    auto rr = __builtin_amdgcn_permlane32_swap(__float_as_uint(pmax), __float_as_uint(pmax), false, false);
    return fmaxf(__uint_as_float(rr[0]), __uint_as_float(rr[1]));
}
template <bool FIRST> __device__ __forceinline__ float decide9(f32x16& p0, f32x16& p1, float pmax, float& mhat, f32x16& negm) {
    float al = 1.f;
    if (FIRST || __builtin_expect(__any(pmax > THR2_8), 0)) { const float dl = FIRST ? pmax : fmaxf(pmax, 0.f); mhat += dl;
#pragma unroll
        for (int r = 0; r < 16; ++r) { p0[r] -= dl; p1[r] -= dl; }
#pragma unroll
        for (int r = 0; r < 16; ++r) negm[r] = -mhat;
        asm volatile("" : "+v"(negm));
        al = __builtin_amdgcn_exp2f(-dl); }
    return al;
}
__device__ __forceinline__ void finishSM9(f32x16& p0, f32x16& p1, i32x8& pa) {
#pragma unroll
    for (int r = 0; r < 16; ++r) p1[r] = __builtin_amdgcn_exp2f(p1[r]);
#pragma unroll
    for (int w = 0; w < 4; ++w) { pa[w] = (int)pack4_fp8(p0[4 * w], p0[4 * w + 1], p0[4 * w + 2], p0[4 * w + 3]); pa[4 + w] = (int)pack4_fp8(p1[4 * w], p1[4 * w + 1], p1[4 * w + 2], p1[4 * w + 3]); }
}
__device__ __forceinline__ float pv_sm9(f32x16 (&o)[4], f32x16& lacc, const LAS unsigned char* Vs, const i32x8& pa, int r32, int hi, f32x16& p0, f32x16& p1, float& mhat, f32x16& negm) {
    const i32x8 ones = {0x38383838, 0x38383838, 0x38383838, 0x38383838, 0x38383838, 0x38383838, 0x38383838, 0x38383838};
    i32x8 vf = v8_frag(Vs, 0, r32, hi);
    float pmax = p0[0];
#pragma unroll
    for (int r = 1; r < 16; ++r) pmax = fmaxf(pmax, p0[r]);
    o[0] = MFMA8(pa, vf, o[0]);
    vf = v8_frag(Vs, 1, r32, hi);
#pragma unroll
    for (int r = 0; r < 16; ++r) pmax = fmaxf(pmax, p1[r]);
    { auto rr = __builtin_amdgcn_permlane32_swap(__float_as_uint(pmax), __float_as_uint(pmax), false, false);
      pmax = fmaxf(__uint_as_float(rr[0]), __uint_as_float(rr[1])); }
    o[1] = MFMA8(pa, vf, o[1]);
    vf = v8_frag(Vs, 2, r32, hi);
    lacc = MFMA8(pa, ones, lacc);
    const float al = decide9<false>(p0, p1, pmax, mhat, negm);
    o[2] = MFMA8(pa, vf, o[2]);
    vf = v8_frag(Vs, 3, r32, hi);
    o[3] = MFMA8(pa, vf, o[3]);
#pragma unroll
    for (int r = 0; r < 16; ++r) p0[r] = __builtin_amdgcn_exp2f(p0[r]);
    return al;
}
__device__ __forceinline__ void attn_unit89(int b, int h, int qb, const bf16* Qraw, const unsigned char* KF8, const unsigned char* V8, const bf16* GA, bf16* ATTG,
                                            const float* gq, const float* COS, const float* SIN, LAS unsigned char* lds, const int wid) {
    const int lane = lane_id_opaque(), r32 = lane & 31, hi = lane >> 5;
    LAS float* al_l = (LAS float*)(lds + L88_WS) + wid * 64;
    const int tok0 = b * SEQ + qb * 256 + wid * 32;
    i32x8 qf[3];
    {
        const int tok = tok0 + r32; const bf16* qp = Qraw + (size_t)tok * (NH * DQK) + h * DQK;
        v4u raw[12]; float ss = 0.f;
#pragma unroll
        for (int c = 0; c < 4; ++c) { raw[c] = *(const v4u*)(qp + 32 * hi + 8 * c); raw[4 + c] = *(const v4u*)(qp + 64 + 32 * hi + 8 * c); }
#pragma unroll
        for (int c = 0; c < 2; ++c) { raw[8 + c] = *(const v4u*)(qp + 128 + 16 * hi + 8 * c); raw[10 + c] = *(const v4u*)(qp + 160 + 16 * hi + 8 * c); }
#pragma unroll
        for (int c = 0; c < 12; ++c) { float f[8]; unpack8(raw[c], f);
#pragma unroll
            for (int j = 0; j < 8; ++j) ss += f[j] * f[j]; }
        ss += __shfl_xor(ss, 32);
        const float rs = (1.0f / sqrtf(ss * (1.f / DQK) + EPS)) * CQ8;
#pragma unroll
        for (int s2 = 0; s2 < 2; ++s2)
#pragma unroll
            for (int c = 0; c < 4; ++c) { float f[8]; unpack8(raw[4 * s2 + c], f); const float* gp = gq + 64 * s2 + 32 * hi + 8 * c; const f32x4 g0 = *(const f32x4*)gp, g1 = *(const f32x4*)(gp + 4);
                qf[s2][2 * c] = (int)pack4_fp8(f[0] * rs * g0[0], f[1] * rs * g0[1], f[2] * rs * g0[2], f[3] * rs * g0[3]);
                qf[s2][2 * c + 1] = (int)pack4_fp8(f[4] * rs * g1[0], f[5] * rs * g1[1], f[6] * rs * g1[2], f[7] * rs * g1[3]); }
#pragma unroll
        for (int c = 0; c < 2; ++c) { float f1[8], f2[8], o1[8], o2[8]; unpack8(raw[8 + c], f1); unpack8(raw[10 + c], f2);
#pragma unroll
            for (int j = 0; j < 8; ++j) { const int i = 16 * hi + 8 * c + j; const float cs = COS[(size_t)tok * 32 + i], sn = SIN[(size_t)tok * 32 + i];
                const float v1 = f1[j] * rs * gq[DNOPE + i], v2 = f2[j] * rs * gq[DNOPE + 32 + i];
                o1[j] = v1 * cs - v2 * sn; o2[j] = v2 * cs + v1 * sn; }
            qf[2][2 * c] = (int)pack4_fp8(o1[0], o1[1], o1[2], o1[3]); qf[2][2 * c + 1] = (int)pack4_fp8(o1[4], o1[5], o1[6], o1[7]);
            qf[2][4 + 2 * c] = (int)pack4_fp8(o2[0], o2[1], o2[2], o2[3]); qf[2][4 + 2 * c + 1] = (int)pack4_fp8(o2[4], o2[5], o2[6], o2[7]); }
    }
    float mhat = 0.f; f32x16 o[4] = {}; f32x16 lacc = {}; f32x16 negm = {}; asm volatile("" : "+v"(negm));
    const unsigned char* Kg = KF8 + (size_t)(((b & 1) * NH + h) * 32) * K8_BYTES + lane * 16;
    const unsigned char* Vg = V8 + (size_t)((b * NH + h) * 32) * V8_BYTES + lane * 16;
    LAS unsigned char* K_lds = lds + L88_K; LAS unsigned char* V_lds = lds + L88_V;
    const int kp1 = (wid + 8 < 12) ? wid + 8 : wid + 4;
#define DMA_K(t, slot) do { __builtin_amdgcn_global_load_lds((const unsigned*)(Kg + (size_t)(t) * K8_BYTES + wid * 1024), (LAS unsigned*)(K_lds + (slot) * K8_SLOT + wid * 1024), 16, 0, 0); \
        __builtin_amdgcn_global_load_lds((const unsigned*)(Kg + (size_t)(t) * K8_BYTES + kp1 * 1024), (LAS unsigned*)(K_lds + (slot) * K8_SLOT + (wid + 8) * 1024), 16, 0, 0); } while (0)
#define DMA_V(t, slot) __builtin_amdgcn_global_load_lds((const unsigned*)(Vg + (size_t)(t) * V8_BYTES + wid * 1024), (LAS unsigned*)(V_lds + (slot) * V8_BYTES + wid * 1024), 16, 0, 0)
#define WAIT_BAR(N) asm volatile("s_waitcnt vmcnt(" #N ")\n\ts_barrier" ::: "memory")
#define RESC(a) do { if (__any((a) < 1.f)) { if (hi == 0) al_l[r32] = (a); asm volatile("s_waitcnt lgkmcnt(0)" ::: "memory"); \
    _Pragma("unroll") for (int r = 0; r < 16; ++r) { const float f_ = al_l[crow(r, hi)]; lacc[r] *= f_; _Pragma("unroll") for (int d = 0; d < 4; ++d) o[d][r] *= f_; } } } while (0)
    f32x16 pA0, pA1, pB0, pB1; float alA, alB; i32x8 pa; constexpr int NT = SEQ / 64;
    DMA_K(0, 0); DMA_V(0, 0); DMA_K(1, 1);
    WAIT_BAR(0);
    DMA_K(2, 2); DMA_V(1, 1);
    qkt8n(pA0, pA1, K_lds, qf, negm, r32, hi);
    { const float pm = rowmax32(pA0, pA1); alA = decide9<true>(pA0, pA1, pm, mhat, negm);
#pragma unroll
      for (int r = 0; r < 16; ++r) pA0[r] = __builtin_amdgcn_exp2f(pA0[r]); }
    WAIT_BAR(3);
    int sk = 1, sv = 0;
#define NEXT3(x) ((x) == 2 ? 0 : (x) + 1)
#define PREV3(x) ((x) == 0 ? 2 : (x) - 1)
    for (int j = 1; j + 1 < NT; j += 2) {
        DMA_K(j + 2, PREV3(sk)); DMA_V(j + 1, NEXT3(sk));
        SBAR(); qkt8n(pB0, pB1, K_lds + sk * K8_SLOT, qf, negm, r32, hi);
        finishSM9(pA0, pA1, pa); SBAR();
        alB = pv_sm9(o, lacc, V_lds + sv * V8_BYTES, pa, r32, hi, pB0, pB1, mhat, negm);
        RESC(alB);
        WAIT_BAR(3);
        sk = NEXT3(sk); sv = NEXT3(sv);
        const bool more = (j + 3 < NT);
        if (more) DMA_K(j + 3, PREV3(sk));
        DMA_V(j + 2, NEXT3(sk));
        SBAR(); qkt8n(pA0, pA1, K_lds + sk * K8_SLOT, qf, negm, r32, hi);
        finishSM9(pB0, pB1, pa); SBAR();
        alA = pv_sm9(o, lacc, V_lds + sv * V8_BYTES, pa, r32, hi, pA0, pA1, mhat, negm);
        RESC(alA);
        if (more) WAIT_BAR(3); else WAIT_BAR(1);
        sk = NEXT3(sk); sv = NEXT3(sv);
    }
    SBAR(); qkt8n(pB0, pB1, K_lds + sk * K8_SLOT, qf, negm, r32, hi);
    finishSM9(pA0, pA1, pa); SBAR();
    alB = pv_sm9(o, lacc, V_lds + sv * V8_BYTES, pa, r32, hi, pB0, pB1, mhat, negm);
    RESC(alB);
    WAIT_BAR(0);
    sv = NEXT3(sv);
    finishSM9(pB0, pB1, pa); SBAR();
    { const i32x8 ones = {0x38383838, 0x38383838, 0x38383838, 0x38383838, 0x38383838, 0x38383838, 0x38383838, 0x38383838};
      pv88(o, V_lds + sv * V8_BYTES, pa, r32, hi); lacc = MFMA8(pa, ones, lacc); }
    { unsigned short gv[16][4];
#pragma unroll
      for (int r = 0; r < 16; ++r) { const size_t ro = (size_t)(tok0 + crow(r, hi)) * 2048 + h * DV + r32;
#pragma unroll
          for (int d0 = 0; d0 < 4; ++d0) gv[r][d0] = GA[ro + d0 * 32]; }
#pragma unroll
      for (int r = 0; r < 16; ++r) { const int orow = crow(r, hi); const float rl = __builtin_amdgcn_rcpf(lacc[r]);
          if (MK_BA_FP8) { unsigned char* wp = (unsigned char*)ATTG + (size_t)(tok0 + orow) * (2 * ACAT_LD) + 2 * CW + h * DV + r32;
              const float sc = rl * ATT8_SCALE;
              const unsigned w4 = pack4_fp8(o[0][r] * sc * siluf_(bflo((unsigned)gv[r][0])), o[1][r] * sc * siluf_(bflo((unsigned)gv[r][1])), o[2][r] * sc * siluf_(bflo((unsigned)gv[r][2])), o[3][r] * sc * siluf_(bflo((unsigned)gv[r][3])));
              wp[0] = (unsigned char)w4; wp[32] = (unsigned char)(w4 >> 8); wp[64] = (unsigned char)(w4 >> 16); wp[96] = (unsigned char)(w4 >> 24); }
          else { const size_t wo = (size_t)(tok0 + orow) * ACAT_LD + CW + h * DV + r32;
#pragma unroll
              for (int d0 = 0; d0 < 4; ++d0) { const float g = bflo((unsigned)gv[r][d0]); ATTG[wo + d0 * 32] = (bf16)f2bf(o[d0][r] * rl * siluf_(g)); } } } }
    WAIT_BAR(0);
#undef DMA_K
#undef DMA_V
#undef WAIT_BAR
#undef NEXT3
#undef PREV3
#undef RESC
}
constexpr int NSLOT4 = 4, L90_K = 0, L90_V = NSLOT4 * K8_SLOT, L90_WS = L90_V + NSLOT4 * V8_BYTES, L90_END = L90_WS + NWAVES * 256;
static_assert(L90_END <= RING_BYTES, "attention (4-slot rings) LDS");
__device__ __forceinline__ void attn_unit90(int b, int h, int qb, const bf16* Qraw, const unsigned char* KF8, const unsigned char* V8, const bf16* GA, bf16* ATTG,
                                            const float* gq, const float* COS, const float* SIN, LAS unsigned char* lds, const int wid) {
    const int lane = lane_id_opaque(), r32 = lane & 31, hi = lane >> 5;
    LAS float* al_l = (LAS float*)(lds + L90_WS) + wid * 64;
    const int tok0 = b * SEQ + qb * 256 + wid * 32;
    const unsigned char* Kg = KF8 + (size_t)(((b & 1) * NH + h) * 32) * K8_BYTES + lane * 16;
    const unsigned char* Vg = V8 + (size_t)((b * NH + h) * 32) * V8_BYTES + lane * 16;
    LAS unsigned char* K_lds = lds + L90_K; LAS unsigned char* V_lds = lds + L90_V;
    const int kp1 = (wid + 8 < 12) ? wid + 8 : wid + 4;
#define DMA_K(t, slot) do { __builtin_amdgcn_global_load_lds((const unsigned*)(Kg + (size_t)(t) * K8_BYTES + wid * 1024), (LAS unsigned*)(K_lds + (slot) * K8_SLOT + wid * 1024), 16, 0, 0); \
        __builtin_amdgcn_global_load_lds((const unsigned*)(Kg + (size_t)(t) * K8_BYTES + kp1 * 1024), (LAS unsigned*)(K_lds + (slot) * K8_SLOT + (wid + 8) * 1024), 16, 0, 0); } while (0)
#define DMA_V(t, slot) __builtin_amdgcn_global_load_lds((const unsigned*)(Vg + (size_t)(t) * V8_BYTES + wid * 1024), (LAS unsigned*)(V_lds + (slot) * V8_BYTES + wid * 1024), 16, 0, 0)
#define WAIT_BAR(N) asm volatile("s_waitcnt vmcnt(" #N ")\n\ts_barrier" ::: "memory")
    DMA_K(0, 0); DMA_V(0, 0); DMA_K(1, 1); DMA_K(2, 2); DMA_V(1, 1);
    i32x8 qf[3];
    {
        const int tok = tok0 + r32;
#if MK_Q_FP8
#define UNPACK_Q(w, f) unpack8_f8(w, f)
        const unsigned char* qp = (const unsigned char*)Qraw + (size_t)tok * (NH * DQK) + h * DQK;
        v2u raw[12]; float ss = 0.f;
#pragma unroll
        for (int c = 0; c < 4; ++c) { raw[c] = *(const v2u*)(qp + 32 * hi + 8 * c); raw[4 + c] = *(const v2u*)(qp + 64 + 32 * hi + 8 * c); }
#pragma unroll
        for (int c = 0; c < 2; ++c) { raw[8 + c] = *(const v2u*)(qp + 128 + 16 * hi + 8 * c); raw[10 + c] = *(const v2u*)(qp + 160 + 16 * hi + 8 * c); }
#else
#define UNPACK_Q(w, f) unpack8(w, f)
        const bf16* qp = Qraw + (size_t)tok * (NH * DQK) + h * DQK;
        v4u raw[12]; float ss = 0.f;
#pragma unroll
        for (int c = 0; c < 4; ++c) { raw[c] = *(const v4u*)(qp + 32 * hi + 8 * c); raw[4 + c] = *(const v4u*)(qp + 64 + 32 * hi + 8 * c); }
#pragma unroll
        for (int c = 0; c < 2; ++c) { raw[8 + c] = *(const v4u*)(qp + 128 + 16 * hi + 8 * c); raw[10 + c] = *(const v4u*)(qp + 160 + 16 * hi + 8 * c); }
#endif
#pragma unroll
        for (int c = 0; c < 12; ++c) { float f[8]; UNPACK_Q(raw[c], f);
#pragma unroll
            for (int j = 0; j < 8; ++j) ss += f[j] * f[j]; }
        ss += __shfl_xor(ss, 32);
        const float rs = MK_Q_FP8 ? (1.0f / sqrtf(ss * (1.f / (64.f * DQK)) + EPS)) * (CQ8 * 0.125f) : (1.0f / sqrtf(ss * (1.f / DQK) + EPS)) * CQ8;
#pragma unroll
        for (int s2 = 0; s2 < 2; ++s2)
#pragma unroll
            for (int c = 0; c < 4; ++c) { float f[8]; UNPACK_Q(raw[4 * s2 + c], f); const float* gp = gq + 64 * s2 + 32 * hi + 8 * c; const f32x4 g0 = *(const f32x4*)gp, g1 = *(const f32x4*)(gp + 4);
                qf[s2][2 * c] = (int)pack4_fp8(f[0] * rs * g0[0], f[1] * rs * g0[1], f[2] * rs * g0[2], f[3] * rs * g0[3]);
                qf[s2][2 * c + 1] = (int)pack4_fp8(f[4] * rs * g1[0], f[5] * rs * g1[1], f[6] * rs * g1[2], f[7] * rs * g1[3]); }
#pragma unroll
        for (int c = 0; c < 2; ++c) { float f1[8], f2[8], o1[8], o2[8]; UNPACK_Q(raw[8 + c], f1); UNPACK_Q(raw[10 + c], f2);
#pragma unroll
            for (int j = 0; j < 8; ++j) { const int i = 16 * hi + 8 * c + j; const float cs = COS[(size_t)tok * 32 + i], sn = SIN[(size_t)tok * 32 + i];
                const float v1 = f1[j] * rs * gq[DNOPE + i], v2 = f2[j] * rs * gq[DNOPE + 32 + i];
                o1[j] = v1 * cs - v2 * sn; o2[j] = v2 * cs + v1 * sn; }
            qf[2][2 * c] = (int)pack4_fp8(o1[0], o1[1], o1[2], o1[3]); qf[2][2 * c + 1] = (int)pack4_fp8(o1[4], o1[5], o1[6], o1[7]);
            qf[2][4 + 2 * c] = (int)pack4_fp8(o2[0], o2[1], o2[2], o2[3]); qf[2][4 + 2 * c + 1] = (int)pack4_fp8(o2[4], o2[5], o2[6], o2[7]); }
    }
    float mhat = 0.f; f32x16 o[4] = {}; f32x16 lacc = {}; f32x16 negm = {}; asm volatile("" : "+v"(negm));
#define RESC(a) do { if (__any((a) < 1.f)) { if (hi == 0) al_l[r32] = (a); asm volatile("s_waitcnt lgkmcnt(0)" ::: "memory"); \
    _Pragma("unroll") for (int r = 0; r < 16; ++r) { const float f_ = al_l[crow(r, hi)]; lacc[r] *= f_; _Pragma("unroll") for (int d = 0; d < 4; ++d) o[d][r] *= f_; } } } while (0)
    f32x16 pA0, pA1, pB0, pB1; float alA, alB; i32x8 pa; constexpr int NT = SEQ / 64;
    WAIT_BAR(0);
    qkt8n(pA0, pA1, K_lds, qf, negm, r32, hi);
    { const float pm = rowmax32(pA0, pA1); alA = decide9<true>(pA0, pA1, pm, mhat, negm);
#pragma unroll
      for (int r = 0; r < 16; ++r) pA0[r] = __builtin_amdgcn_exp2f(pA0[r]); }
    WAIT_BAR(0);
    for (int j = 1; j + 1 < NT; j += 2) {
        DMA_K(j + 2, (j + 2) & 3); if (j + 3 < NT) DMA_K(j + 3, (j + 3) & 3);
        DMA_V(j + 1, (j + 1) & 3); DMA_V(j + 2, (j + 2) & 3);
        SBAR(); qkt8n(pB0, pB1, K_lds + (j & 3) * K8_SLOT, qf, negm, r32, hi);
        finishSM9(pA0, pA1, pa); SBAR();
        alB = pv_sm9(o, lacc, V_lds + ((j - 1) & 3) * V8_BYTES, pa, r32, hi, pB0, pB1, mhat, negm);
        RESC(alB);
        SBAR(); qkt8n(pA0, pA1, K_lds + ((j + 1) & 3) * K8_SLOT, qf, negm, r32, hi);
        finishSM9(pB0, pB1, pa); SBAR();
        alA = pv_sm9(o, lacc, V_lds + (j & 3) * V8_BYTES, pa, r32, hi, pA0, pA1, mhat, negm);
        RESC(alA);
        WAIT_BAR(0);
    }
    SBAR(); qkt8n(pB0, pB1, K_lds + ((NT - 1) & 3) * K8_SLOT, qf, negm, r32, hi);
    finishSM9(pA0, pA1, pa); SBAR();
    alB = pv_sm9(o, lacc, V_lds + ((NT - 2) & 3) * V8_BYTES, pa, r32, hi, pB0, pB1, mhat, negm);
    RESC(alB);
    finishSM9(pB0, pB1, pa); SBAR();
    { const i32x8 ones = {0x38383838, 0x38383838, 0x38383838, 0x38383838, 0x38383838, 0x38383838, 0x38383838, 0x38383838};
      pv88(o, V_lds + ((NT - 1) & 3) * V8_BYTES, pa, r32, hi); lacc = MFMA8(pa, ones, lacc); }
    if (MK_ATT_PERM && MK_GA_FP8 && MK_BA_FP8) { unsigned gw[16]; const unsigned char* G8 = (const unsigned char*)GA;
#pragma unroll
      for (int r = 0; r < 16; ++r) gw[r] = *(const unsigned*)(G8 + (size_t)(tok0 + crow(r, hi)) * 2048 + h * DV + 4 * r32);
#pragma unroll
      for (int r = 0; r < 16; ++r) { const int orow = crow(r, hi); const float rl = __builtin_amdgcn_rcpf(lacc[r]);
          unsigned char* wp = (unsigned char*)ATTG + (size_t)(tok0 + orow) * (2 * ACAT_LD) + 2 * CW + h * DV + 4 * r32;
          const float sc = rl * (ATT8_SCALE / 16.f);
          *(unsigned*)wp = pack4_fp8(o[0][r] * sc * __builtin_amdgcn_cvt_f32_fp8((int)gw[r], 0), o[1][r] * sc * __builtin_amdgcn_cvt_f32_fp8((int)gw[r], 1),
                                     o[2][r] * sc * __builtin_amdgcn_cvt_f32_fp8((int)gw[r], 2), o[3][r] * sc * __builtin_amdgcn_cvt_f32_fp8((int)gw[r], 3)); } }
    else
    if (MK_GA_FP8 && MK_BA_FP8) { unsigned char gb[16][4]; const unsigned char* G8 = (const unsigned char*)GA;
#pragma unroll
      for (int r = 0; r < 16; ++r) { const size_t ro = (size_t)(tok0 + crow(r, hi)) * 2048 + h * DV + r32;
#pragma unroll
          for (int d0 = 0; d0 < 4; ++d0) gb[r][d0] = G8[ro + d0 * 32]; }
#pragma unroll
      for (int r = 0; r < 16; ++r) { const int orow = crow(r, hi); const float rl = __builtin_amdgcn_rcpf(lacc[r]);
          unsigned char* wp = (unsigned char*)ATTG + (size_t)(tok0 + orow) * (2 * ACAT_LD) + 2 * CW + h * DV + r32;
          const float sc = rl * (ATT8_SCALE / 16.f);
          const unsigned w4 = pack4_fp8(o[0][r] * sc * __builtin_amdgcn_cvt_f32_fp8((int)gb[r][0], 0), o[1][r] * sc * __builtin_amdgcn_cvt_f32_fp8((int)gb[r][1], 0),
                                        o[2][r] * sc * __builtin_amdgcn_cvt_f32_fp8((int)gb[r][2], 0), o[3][r] * sc * __builtin_amdgcn_cvt_f32_fp8((int)gb[r][3], 0));
          wp[0] = (unsigned char)w4; wp[32] = (unsigned char)(w4 >> 8); wp[64] = (unsigned char)(w4 >> 16); wp[96] = (unsigned char)(w4 >> 24); } }
    else
    { unsigned short gv[16][4];
#pragma unroll
      for (int r = 0; r < 16; ++r) { const size_t ro = (size_t)(tok0 + crow(r, hi)) * 2048 + h * DV + r32;
#pragma unroll
          for (int d0 = 0; d0 < 4; ++d0) gv[r][d0] = GA[ro + d0 * 32]; }
#pragma unroll
      for (int r = 0; r < 16; ++r) { const int orow = crow(r, hi); const float rl = __builtin_amdgcn_rcpf(lacc[r]);
          if (MK_BA_FP8) { unsigned char* wp = (unsigned char*)ATTG + (size_t)(tok0 + orow) * (2 * ACAT_LD) + 2 * CW + h * DV + r32;
              const float sc = rl * ATT8_SCALE;
              const unsigned w4 = pack4_fp8(o[0][r] * sc * siluf_(bflo((unsigned)gv[r][0])), o[1][r] * sc * siluf_(bflo((unsigned)gv[r][1])), o[2][r] * sc * siluf_(bflo((unsigned)gv[r][2])), o[3][r] * sc * siluf_(bflo((unsigned)gv[r][3])));
              wp[0] = (unsigned char)w4; wp[32] = (unsigned char)(w4 >> 8); wp[64] = (unsigned char)(w4 >> 16); wp[96] = (unsigned char)(w4 >> 24); }
          else { const size_t wo = (size_t)(tok0 + orow) * ACAT_LD + CW + h * DV + r32;
#pragma unroll
              for (int d0 = 0; d0 < 4; ++d0) { const float g = bflo((unsigned)gv[r][d0]); ATTG[wo + d0 * 32] = (bf16)f2bf(o[d0][r] * rl * siluf_(g)); } } } }
    WAIT_BAR(0);
#undef DMA_K
#undef DMA_V
#undef WAIT_BAR
#undef NEXT3
#undef PREV3
#undef RESC
}
#undef MFMA8
#undef SBAR
}

constexpr int PER_PHASE = 9;
__global__ void __launch_bounds__(NWAVES * 64, 2) mk_fwd(Args args) {
    extern __shared__ __attribute__((aligned(16))) unsigned char lds_raw[];
    Frame F;
    F.lds = (LAS unsigned char*)lds_raw;
    volatile LAS unsigned* MISC = (volatile LAS unsigned*)(F.lds + MISC_OFF);
    F.wave = __builtin_amdgcn_readfirstlane(threadIdx.x >> 6);
    F.G = gridDim.x; { const int bx = blockIdx.x; F.vcu = (F.G % 8 == 0) ? (bx % 8) * (F.G / 8) + bx / 8 : bx; }
    unsigned char* ws = args.ws;
    gu32* ctl = (gu32*)(ws + WS_CTL);
    for (int u = threadIdx.x; u < (LDS_BYTES - LDSCTL_OFF) / 4; u += NWAVES * 64) ((LAS unsigned*)(F.lds + LDSCTL_OFF))[u] = 0u;
    __syncthreads();
    XcdBarrier bar; bar.bar = (unsigned*)(ctl + CW_BAR); bar.x = 0; bar.st = nullptr;
    if (MK_N_LAUNCHES == 1) bar = xcd_barrier_post((unsigned*)(ctl + CW_BAR), MISC + 8);
    const int lo = args.ph_lo, hi = args.ph_hi;
#define IN(k) (lo <= (k) && (k) < hi && ((MK_PHASE_MASK >> (k)) & 1))
#define REPS(k) for (int rep_ = 0; rep_ < 1 + ((MK_REPEAT_MASK >> (k)) & 1); ++rep_)
#define SEAM(k) do { if ((k) + 1 < hi) { if (MK_N_LAUNCHES == 1) xcd_barrier(bar); } } while (0)
    const int G = F.G, bx = (int)blockIdx.x;

    if (lo <= 0 && 0 < hi) { REPS(0) if (IN(0)) p0_prologue(F, args); SEAM(0); if (MK_PROBE == 1) { for (int e = 0; e < 8; ++e) xcd_barrier(bar); } }
    if (lo <= 1 && 1 < hi) {
        REPS(1) if (IN(1)) {
            const bool f8first = ((bx >> 3) & 1) != 0;
            if (!f8first) {
            { pg8::Gemm g{(const bf16*)(ws + WS_H), (const bf16*)(ws + WS_WIN), MTOK, P1_NT16 * 256, DM}; pg8::StaticOrder S; S.init(MTOK, P1_NT16 * 256, G, bx);
              EpiZ E{ws, 0};
              pg8::gemm_phase<EpiZ, pg8::StaticOrder, true, true>(F.lds + RING_OFF, g, S, E, F.wave); }
            }
            { pg8::Gemm g{(const bf16*)(ws + WS_H8), (const bf16*)(ws + WS_WIN8), MTOK, P1_NT8 * 256, DM / 2}; pg8::StaticOrder S; S.init(MTOK, P1_NT8 * 256, G, bx);
              EpiZ E{ws, 1};
              pg8::gemm_phase<EpiZ, pg8::StaticOrder, true, true, -1, 0>(F.lds + RING_OFF, g, S, E, F.wave); }
            if (f8first) {
            { pg8::Gemm g{(const bf16*)(ws + WS_H), (const bf16*)(ws + WS_WIN), MTOK, P1_NT16 * 256, DM}; pg8::StaticOrder S; S.init(MTOK, P1_NT16 * 256, G, bx);
              EpiZ E{ws, 0};
              pg8::gemm_phase<EpiZ, pg8::StaticOrder, true, true>(F.lds + RING_OFF, g, S, E, F.wave); }
            }
            { const int lane = lane_id_opaque(); p0_items(args, (LAS float*)(F.lds + RING_OFF), F.wave, lane, bx, G, P0_EARLY + P0_IN_P3, P0_NITEMS); }
            __syncthreads(); }
        SEAM(1); }
    if (lo <= 2 && 2 < hi) { REPS(2) if (IN(2)) p2_rowpass(F, args); SEAM(2); }
    for (int rp34 = 0; rp34 < (MK_PROBE == 2 ? 2 : 1); ++rp34) {
    if (lo <= 3 && 3 < hi) {
        REPS(3) if (IN(3)) {
            { pg8::Gemm g{(const bf16*)(ws + WS_QLAT), (const bf16*)(ws + WS_WUQ), MTOK, NH * DQK, QR / 2}; pg8::StaticOrder S; S.init(MTOK, NH * DQK, G, bx);
              if (MK_Q_FP8 && MK_ATT_FP8 == 5) { EpiF8 E{ws + WS_Q, NH * DQK, 8.0f};
              pg8::gemm_phase<EpiF8, pg8::StaticOrder, true, true, -1, 0>(F.lds + RING_OFF, g, S, E, F.wave); }
              else { EpiBf16 E{(bf16*)(ws + WS_Q), NH * DQK};
              pg8::gemm_phase<EpiBf16, pg8::StaticOrder, true, true, -1, 0>(F.lds + RING_OFF, g, S, E, F.wave); } }
            { const int nfull = (MTOK / 256) * (NH * DQK / 256) % G;
              if (nfull != 0 && bx < nfull) { const int lane = lane_id_opaque(); p0_items(args, (LAS float*)(F.lds + RING_OFF), F.wave, lane, bx, nfull, P0_EARLY, P0_EARLY + P0_IN_P3); __syncthreads(); }
              if (nfull != 0 && bx >= nfull) { pg8::Gemm g2{(const bf16*)(ws + WS_PB), (const bf16*)(ws + WS_WPP), MTOK, DM, PLE}; pg8::StaticOrder S2; S2.init(MTOK, DM, G - nfull, bx - nfull);
                  EpiBf16 E2{(bf16*)(ws + WS_PPROJ), DM};
                  pg8::gemm_phase<EpiBf16, pg8::StaticOrder, true, true>(F.lds + RING_OFF, g2, S2, E2, F.wave); } }
            { pg8::Gemm g{(const bf16*)(ws + WS_KVLAT), (const bf16*)(ws + WS_WUKV), MTOK, NH * 256, KVR}; pg8::StaticOrder S; S.init(MTOK, NH * 256, G, bx);
              EpiKV E{(bf16*)(ws + WS_KF), (bf16*)(ws + WS_VT), (const float*)(ws + WS_RK), (const float*)(ws + WS_SSQKPE), args.k_norm_g, (LAS float*)(F.lds + EPI_RED_OFF), ws + WS_KF8_LO, ws + WS_KF8_HI, 0};
              pg8::gemm_phase<EpiKV, pg8::StaticOrder, true, true>(F.lds + RING_OFF, g, S, E, F.wave); }
        }
        SEAM(3); }
    }
    if (lo <= 5 && 5 < hi) {
        REPS(5) if (IN(5)) {
            for (int U = F.vcu; U < BATCH * NH * 8; U += G) { const int bh = U >> 3, qb = U & 7;
                if (MK_ATT_FP8 == 5) att::attn_unit90(bh >> 4, bh & 15, qb, (const bf16*)(ws + WS_Q), ws + (((bh >> 4) < 2) ? WS_KF8_LO : WS_KF8_HI), ws + WS_VT, (const bf16*)(ws + WS_GA),
                                (bf16*)((unsigned char*)args.out + OUT_ACAT), args.q_norm_g, (const float*)(ws + WS_COS), (const float*)(ws + WS_SIN), F.lds + RING_OFF, F.wave);
                if (MK_ATT_FP8 == 4) att::attn_unit89(bh >> 4, bh & 15, qb, (const bf16*)(ws + WS_Q), ws + (((bh >> 4) < 2) ? WS_KF8_LO : WS_KF8_HI), ws + WS_VT, (const bf16*)(ws + WS_GA),
                                (bf16*)((unsigned char*)args.out + OUT_ACAT), args.q_norm_g, (const float*)(ws + WS_COS), (const float*)(ws + WS_SIN), F.lds + RING_OFF, F.wave);
                if (MK_ATT_FP8 == 3) att::attn_unit88(bh >> 4, bh & 15, qb, (const bf16*)(ws + WS_Q), ws + (((bh >> 4) < 2) ? WS_KF8_LO : WS_KF8_HI), ws + WS_VT, (const bf16*)(ws + WS_GA),
                                (bf16*)((unsigned char*)args.out + OUT_ACAT), args.q_norm_g, (const float*)(ws + WS_COS), (const float*)(ws + WS_SIN), F.lds + RING_OFF, F.wave);
                if (MK_ATT_FP8 == 0 || MK_ATT_FP8 == 2) att::attn_unit(bh >> 4, bh & 15, qb, (const bf16*)(ws + WS_Q), (const bf16*)(ws + WS_KF), (const bf16*)(ws + WS_VT), (const bf16*)(ws + WS_GA),
                                (bf16*)((unsigned char*)args.out + OUT_ACAT), args.q_norm_g, (const float*)(ws + WS_COS), (const float*)(ws + WS_SIN), F.lds + RING_OFF, F.wave);
                if (MK_ATT_FP8 == 1 || MK_ATT_FP8 == 2) att::attn_unit8<MK_ATT_FP8 == 2>(bh >> 4, bh & 15, qb, (const bf16*)(ws + WS_Q), ws + (((bh >> 4) < 2) ? WS_KF8_LO : WS_KF8_HI), (const bf16*)(ws + WS_VT), (const bf16*)(ws + WS_GA),
                                (bf16*)((unsigned char*)args.out + OUT_ACAT), args.q_norm_g, (const float*)(ws + WS_COS), (const float*)(ws + WS_SIN), F.lds + RING_OFF, F.wave, (float*)(ws + WS_CTL) + CW_CHK); }
        }
        SEAM(5); }
    if (lo <= 6 && 6 < hi) {
        REPS(6) if (IN(6)) {
            { pg8::Gemm g{(const bf16*)((unsigned char*)args.out + OUT_ACAT), (const bf16*)(ws + WS_WCAT), MTOK, DM, ACAT_LD}; pg8::StaticOrder S; S.init(MTOK, DM, G, bx);
              if ((MK_EPI_PIPE & 1) && MK_GATE_FUSE && MK_MC_FP8) { EpiMerge2P E{(const bf16*)(ws + WS_MAMC), (bf16*)(ws + WS_MERGED)};
              pg8::gemm_phase<EpiMerge2P, pg8::StaticOrder, true, true, CW / 64, MK_BA_FP8 ? CW / 64 : (1 << 30), 0x7B7B7B7B>(F.lds + RING_OFF, g, S, E, F.wave); }
              else { EpiMerge2 E{(const bf16*)(ws + WS_MAMC), (bf16*)(ws + WS_MERGED)};
              pg8::gemm_phase<EpiMerge2, pg8::StaticOrder, true, true, CW / 64, MK_BA_FP8 ? CW / 64 : (1 << 30), 0x7B7B7B7B>(F.lds + RING_OFF, g, S, E, F.wave); } }
        }
        SEAM(6); }
    for (int rp78 = 0; rp78 < (MK_PROBE == 3 ? 2 : 1); ++rp78) {
    if (lo <= 7 && 7 < hi) {
        REPS(7) if (IN(7)) { pg8::Gemm g{(const bf16*)(ws + WS_MERGED), (const bf16*)(ws + WS_WOUT), MTOK, DM, DM}; pg8::StaticOrder S; S.init(MTOK, DM, G, bx);
            if ((MK_EPI_PIPE & 2) && MK_X1_BF16) { EpiX1P E{args.x, (float*)(ws + WS_X1F), (bf16*)(ws + WS_X1G), (float*)(ws + WS_SSQ1P)};
            pg8::gemm_phase<EpiX1P, pg8::StaticOrder, true, true>(F.lds + RING_OFF, g, S, E, F.wave); }
            else { EpiX1 E{args.x, (float*)(ws + WS_X1F), (bf16*)(ws + WS_X1G), (float*)(ws + WS_SSQ1P)};
            pg8::gemm_phase<EpiX1, pg8::StaticOrder, true, true>(F.lds + RING_OFF, g, S, E, F.wave); }
 }
        SEAM(7); }
    if (lo <= 8 && 8 < hi) {
        REPS(8) if (IN(8)) {
            if ((MTOK / 256) * (NH * DQK / 256) % G == 0) { pg8::Gemm g{(const bf16*)(ws + WS_PB), (const bf16*)(ws + WS_WPP), MTOK, DM, PLE}; pg8::StaticOrder S; S.init(MTOK, DM, G, bx);
              EpiBf16 E{(bf16*)(ws + WS_PPROJ), DM};
              pg8::gemm_phase<EpiBf16, pg8::StaticOrder, true, true>(F.lds + RING_OFF, g, S, E, F.wave);
              VM_WAIT(); __syncthreads(); }
            { pg8::Gemm g{(const bf16*)(ws + WS_X1G), (const bf16*)(ws + WS_WPG), MTOK, DM, DM}; pg8::StaticOrder S; S.init(MTOK, DM, G, bx);
              if ((MK_EPI_PIPE & 4) && MK_X1_BF16) { EpiOutP E{(const float*)(ws + WS_X1F), args.out, (const bf16*)(ws + WS_PPROJ), (const float*)(ws + WS_SSQ1P), (const bf16*)(ws + WS_X1G)};
              pg8::gemm_phase<EpiOutP, pg8::StaticOrder, true, true>(F.lds + RING_OFF, g, S, E, F.wave); }
              else { EpiOut E{(const float*)(ws + WS_X1F), args.out, (const bf16*)(ws + WS_PPROJ), (const float*)(ws + WS_SSQ1P), (const bf16*)(ws + WS_X1G)};
              pg8::gemm_phase<EpiOut, pg8::StaticOrder, true, true>(F.lds + RING_OFF, g, S, E, F.wave); } }
        }
    }
    if (MK_PROBE == 3 && rp78 == 0) xcd_barrier(bar);
    }
    if (MK_ATT_FP8 == 2 && MK_N_LAUNCHES == 1) {
        xcd_barrier(bar);
        const float dsum = ((const float*)(ws + WS_CTL))[CW_CHK], rsum = ((const float*)(ws + WS_CTL))[CW_CHK + 1];
        if (!(dsum <= 0.04f * rsum) || !(rsum > 0.f)) { const float qn = __builtin_nanf(""); for (int i = bx * 512 + F.wave * 64 + lane_id_opaque(); i < MTOK * DM; i += G * 512) args.out[i] = qn; }
    }
#undef IN
#undef SEAM
}

extern "C" void kernel_launch(void* const* d_in, const int* in_sizes, int n_in, void* d_out, int out_size, void* d_ws, size_t ws_size, hipStream_t stream) {
    static int grid = 0;
    if (grid == 0) {
        if (n_in != 19 || in_sizes[0] != MTOK * DM || out_size != MTOK * DM || ws_size < WS_END) {
            fprintf(stderr, "kernel_launch: shape/workspace mismatch: n_in %d in0 %d out %d ws %zu (need >= %zu); nothing launched\n", n_in, n_in > 0 ? in_sizes[0] : -1, out_size, ws_size, (size_t)WS_END); grid = -1; return; }
        int dev = 0, cus = 0, per_cu = 0;
        if (hipGetDevice(&dev) != hipSuccess || hipDeviceGetAttribute(&cus, hipDeviceAttributeMultiprocessorCount, dev) != hipSuccess) { fprintf(stderr, "kernel_launch: device query failed\n"); grid = -1; return; }
        if (hipFuncSetAttribute((const void*)mk_fwd, hipFuncAttributeMaxDynamicSharedMemorySize, LDS_BYTES) != hipSuccess) { fprintf(stderr, "kernel_launch: hipFuncSetAttribute failed\n"); grid = -1; return; }
        if (hipOccupancyMaxActiveBlocksPerMultiprocessor(&per_cu, (const void*)mk_fwd, NWAVES * 64, LDS_BYTES) != hipSuccess || per_cu < 1) {
            fprintf(stderr, "kernel_launch: occupancy query reports %d workgroups per CU\n", per_cu); (void)hipGetLastError(); grid = -1; return; }
        grid = cus;
    }
    if (grid < 0) return;
    (void)hipMemsetAsync((char*)d_ws + WS_CTL, 0, CTL_ZERO_BYTES, stream);
    Args a{};
    a.x = (const float*)d_in[0]; a.p = (const float*)d_in[1]; a.positions = (const int*)d_in[2]; a.norm_g = (const float*)d_in[3]; a.w_in = (const float*)d_in[4];
    a.q_lat_g = (const float*)d_in[5]; a.kv_lat_g = (const float*)d_in[6]; a.w_uq = (const float*)d_in[7]; a.w_ukv = (const float*)d_in[8]; a.q_norm_g = (const float*)d_in[9];
    a.k_norm_g = (const float*)d_in[10]; a.conv_w = (const float*)d_in[11]; a.conv_b = (const float*)d_in[12]; a.w_ba = (const float*)d_in[13]; a.w_bc = (const float*)d_in[14];
    a.w_out = (const float*)d_in[15]; a.ple_norm_g = (const float*)d_in[16]; a.w_pg = (const float*)d_in[17]; a.w_pp = (const float*)d_in[18];
    a.out = (float*)d_out; a.ws = (unsigned char*)d_ws;
    if (MK_N_LAUNCHES == 1) {
        a.ph_lo = 0; a.ph_hi = PER_PHASE;
        void* kargs[] = {(void*)&a};
        const hipError_t ce = hipLaunchCooperativeKernel((const void*)mk_fwd, dim3(grid), dim3(NWAVES * 64), kargs, LDS_BYTES, stream);
        if (ce != hipSuccess) fprintf(stderr, "kernel_launch: cooperative launch failed: %s (grid %d)\n", hipGetErrorName(ce), grid);
    } else {
        for (int li = 0; li < PER_PHASE; ++li) { a.ph_lo = li; a.ph_hi = li + 1; hipLaunchKernelGGL(mk_fwd, dim3(grid), dim3(NWAVES * 64), LDS_BYTES, stream, a); }
    }
    const hipError_t le = hipPeekAtLastError();
    if (le != hipSuccess) fprintf(stderr, "kernel_launch: launch failed: %s\n", hipGetErrorName(le));
}
```

```cpp
#include <hip/hip_runtime.h>
#include <hip/hip_bf16.h>
#include <cstdio>
#include <cstdint>

#ifndef MK_N_LAUNCHES
#define MK_N_LAUNCHES 1
#endif
#ifndef MK_PHASE_MASK
#define MK_PHASE_MASK 0x1ff
#endif
#ifndef MK_ATT_FP8
#define MK_ATT_FP8 5
#endif
#ifndef MK_BA_FP8
#define MK_BA_FP8 1
#endif
#ifndef MK_MC_FP8
#define MK_MC_FP8 1
#endif
#ifndef MK_CONV_FUSE
#define MK_CONV_FUSE 1
#endif
#ifndef MK_X1_BF16
#define MK_X1_BF16 1
#endif
#ifndef MK_ZS_BF16
#define MK_ZS_BF16 1
#endif
#ifndef MK_GATE_FUSE
#define MK_GATE_FUSE 1
#endif
#ifndef MK_GA_FP8
#define MK_GA_FP8 1
#endif
#ifndef MK_Q_FP8
#define MK_Q_FP8 1
#endif
#ifndef MK_ATT_PERM
#define MK_ATT_PERM 1
#endif
#ifndef MK_LAT_FUSE
#define MK_LAT_FUSE 3
#endif
#ifndef MK_PP_SPLIT
#define MK_PP_SPLIT 1
#endif
#ifndef MK_NT_IN
#define MK_NT_IN 2
#endif
#ifndef MK_PROBE
#define MK_PROBE 0
#endif
#ifndef MK_REPEAT_MASK
#define MK_REPEAT_MASK 0x000
#endif

__device__ __forceinline__ int lane_id_opaque() { int z = 0; asm volatile("" : "+v"(z)); return (int)__builtin_amdgcn_mbcnt_hi(~0u, __builtin_amdgcn_mbcnt_lo(~0u, (unsigned)z)); }
namespace pg8 {
#define PG8_LAS __attribute__((address_space(3)))
typedef unsigned short bf16_t;
typedef short bf16x8 __attribute__((ext_vector_type(8)));
typedef float f32x4 __attribute__((ext_vector_type(4)));
typedef unsigned u32x4 __attribute__((ext_vector_type(4)));
typedef int i32x4g __attribute__((ext_vector_type(4)));
constexpr int W8_E8M0 = 0x7A7A7A7A;
constexpr int BM = 256, BK = 64, HALF = 128, HTB = HALF * BK * 2, STAGE_BYTES = 8 * HTB, NXCD = 8, WGM = 8;

__host__ __device__ __forceinline__ int lds_byte(int r, int c) { const int st = (r >> 4) * 2 + (c >> 5), rr = r & 15, cc = c & 31, ob = rr * 64 + cc * 2; return st * 1024 + (ob ^ (((ob >> 9) & 1) << 5)); }
__host__ __device__ __forceinline__ void stage_rc(int b, int& R, int& C) { const int st = b / 1024, sb = b % 1024, swz = sb ^ (((sb >> 9) & 1) << 5); R = (st >> 1) * 16 + swz / 64; C = (st & 1) * 32 + (swz % 64) / 2; }
__host__ __device__ __forceinline__ int perm32(int rho) { const int n = rho >> 4, i = rho & 15; return 8 * (i >> 2) + 4 * n + (i & 3); }

struct Unit { int pm, pn; };
struct Gemm { const bf16_t* A; const bf16_t* Bt; int M, N, K; };

struct StaticOrder {
    int nM, nN, nwg, G, c;
    __host__ __device__ void init(int M, int N, int G_, int c_) { nM = M / BM; nN = N / BM; nwg = nM * nN; G = G_; c = c_; }
    __host__ __device__ bool next(int i, Unit& u) const {
        const long L = (long)i * G + c; if (L >= nwg) return false;
        int wgid = (int)L; { const int q = nwg / NXCD, r = nwg % NXCD, xcd = wgid % NXCD, off = wgid / NXCD; wgid = (xcd < r ? xcd * (q + 1) : r * (q + 1) + (xcd - r) * q) + off; }
        const int nig = WGM * nN, gid = wgid / nig, fm = gid * WGM, gsz = (nM - fm) < WGM ? (nM - fm) : WGM;
        u.pm = fm + ((wgid % nig) % gsz); u.pn = (wgid % nig) / gsz; return true;
    }
    __device__ __forceinline__ void a_ready(const Unit&) const {}
    __device__ __forceinline__ void done(const Unit&) const {}
};

__device__ __forceinline__ unsigned cvt_pk_bf16(float lo, float hi) { unsigned r; asm volatile("v_cvt_pk_bf16_f32 %0, %1, %2" : "=v"(r) : "v"(lo), "v"(hi)); return r; }

template <class Epi, class Sched, bool ALIGN_EPI = false, bool SP2 = false, int HOOK_T = -1, int FP8_T0 = (1 << 30), int A8SC = 0x7F7F7F7F>
__device__ __forceinline__ void gemm_phase(PG8_LAS unsigned char* lds, const Gemm g, const Sched& S, const Epi& E, const int wid) {
    const int lane = lane_id_opaque(), tid = wid * 64 + lane,
              wr = wid >> 2, wc = wid & 3, fr = lane & 15, fq = lane >> 4;
    const int K = g.K, nt = K / BK;
    unsigned voffA[2], voffB[2];
#pragma unroll
    for (int i = 0; i < 2; ++i) { int R, C; stage_rc(tid * 16 + i * 8192, R, C); const int Rb = Epi::PERM ? ((R & ~31) + perm32(R & 31)) : R;
        voffA[i] = (unsigned)(R * K + C) * 2u; voffB[i] = (unsigned)(Rb * K + C) * 2u; }
    const size_t kstep = (size_t)(BK * 2);
    const size_t hstep = (size_t)HALF * K * 2;
    const size_t tstep = 2 * hstep;
    const unsigned ldsw = (unsigned)wid * 1024u;
    const int aoff = lds_byte(wr * 64 + fr, fq * 8), boff = lds_byte(wc * 32 + fr, fq * 8);
#define PG8_SA(b, h) (((b) * 2 + (h)) * HTB)
#define PG8_SB(b, h) ((4 + (b) * 2 + (h)) * HTB)
#define PG8_STAGE(bufoff, gbase, voff) do { _Pragma("unroll") for (int _i = 0; _i < 2; ++_i) \
        __builtin_amdgcn_global_load_lds((const unsigned*)((const char*)(gbase) + (voff)[_i]), (PG8_LAS unsigned*)(lds + (bufoff) + ldsw + _i * 8192), 16, 0, 0); } while (0)
#define PG8_LDA(dst, b, h) do { _Pragma("unroll") for (int m = 0; m < 4; ++m) _Pragma("unroll") for (int k = 0; k < 2; ++k) dst[m][k] = *(const PG8_LAS bf16x8*)(lds + PG8_SA(b, h) + aoff + m * 2048 + k * 1024); } while (0)
#define PG8_LDB(dst, b, h) do { _Pragma("unroll") for (int n = 0; n < 2; ++n) _Pragma("unroll") for (int k = 0; k < 2; ++k) dst[n][k] = *(const PG8_LAS bf16x8*)(lds + PG8_SB(b, h) + boff + n * 2048 + k * 1024); } while (0)
#define PG8_MMA(ai, bj, At, Bt) do { __builtin_amdgcn_s_setprio(1); _Pragma("unroll") for (int m = 0; m < 4; ++m) _Pragma("unroll") for (int n = 0; n < 2; ++n) _Pragma("unroll") for (int k = 0; k < 2; ++k) \
        acc[ai][bj][m][n] = __builtin_amdgcn_mfma_f32_16x16x32_bf16(Bt[n][k], At[m][k], acc[ai][bj][m][n], 0, 0, 0); __builtin_amdgcn_s_setprio(0); } while (0)
#define PG8_CAT8(x0, x1) __builtin_shufflevector(__builtin_bit_cast(i32x4g, x0), __builtin_bit_cast(i32x4g, x1), 0, 1, 2, 3, 4, 5, 6, 7)
#define PG8_MMA8(ai, bj, At, Bt) do { __builtin_amdgcn_s_setprio(1); _Pragma("unroll") for (int m = 0; m < 4; ++m) _Pragma("unroll") for (int n = 0; n < 2; ++n) \
        asm volatile("v_mfma_scale_f32_16x16x128_f8f6f4 %0, %1, %2, %0, %3, %4 op_sel_hi:[0,0,0]" : "+v"(acc[ai][bj][m][n]) : "v"(PG8_CAT8(Bt[n][0], Bt[n][1])), "v"(PG8_CAT8(At[m][0], At[m][1])), "v"(w8sc), "v"(one8sc)); \
        __builtin_amdgcn_s_setprio(0); } while (0)
#define PG8_MMA16A(ai, bj, At, Bt) do { __builtin_amdgcn_s_setprio(1); _Pragma("unroll") for (int m = 0; m < 4; ++m) _Pragma("unroll") for (int n = 0; n < 2; ++n) _Pragma("unroll") for (int k = 0; k < 2; ++k) \
        asm volatile("v_mfma_f32_16x16x32_bf16 %0, %1, %2, %0" : "+v"(acc[ai][bj][m][n]) : "v"(Bt[n][k]), "v"(At[m][k])); __builtin_amdgcn_s_setprio(0); } while (0)
#define PG8_WAIT_V(n) asm volatile("s_waitcnt vmcnt(" #n ")" ::: "memory")
#define PG8_WAIT_L(n) asm volatile("s_waitcnt lgkmcnt(" #n ")" ::: "memory")
#define PG8_BAR __builtin_amdgcn_s_barrier()
#define PG8_SCHED __builtin_amdgcn_sched_barrier(0)
    Unit cur, nxt; int ui = 0;
    if (!S.next(0, cur)) return;
    f32x4 acc[2][2][4][2];
#pragma unroll
    for (int a = 0; a < 2; ++a)
#pragma unroll
        for (int b = 0; b < 2; ++b)
#pragma unroll
            for (int m = 0; m < 4; ++m)
#pragma unroll
                for (int n = 0; n < 2; ++n) acc[a][b][m][n] = (f32x4){0.f, 0.f, 0.f, 0.f};
    bf16x8 At[4][2], B0[2][2], B1[2][2];
    int w8sc = W8_E8M0, one8sc = A8SC; if (FP8_T0 < (1 << 30)) asm volatile("" : "+v"(w8sc), "+v"(one8sc));
    const char* cA = (const char*)g.A + (size_t)cur.pm * tstep; const char* cB = (const char*)g.Bt + (size_t)cur.pn * tstep;
    S.a_ready(cur);
    if constexpr (SP2) {
        PG8_STAGE(PG8_SB(0, 0), cB, voffB); PG8_STAGE(PG8_SB(0, 1), cB + hstep, voffB); PG8_STAGE(PG8_SA(0, 0), cA, voffA); PG8_STAGE(PG8_SA(0, 1), cA + hstep, voffA);
        if (wr == 1) PG8_BAR;
        PG8_WAIT_V(2); PG8_BAR;
        PG8_STAGE(PG8_SB(1, 0), cB + kstep, voffB); PG8_STAGE(PG8_SA(1, 0), cA + kstep, voffA); PG8_STAGE(PG8_SB(1, 1), cB + hstep + kstep, voffB);
        PG8_WAIT_V(6); PG8_BAR;
    } else {
        PG8_STAGE(PG8_SB(0, 0), cB, voffB); PG8_STAGE(PG8_SA(0, 0), cA, voffA); PG8_STAGE(PG8_SB(0, 1), cB + hstep, voffB); PG8_STAGE(PG8_SA(0, 1), cA + hstep, voffA);
        if (wr == 1) PG8_BAR;
        PG8_WAIT_V(4); PG8_BAR;
        PG8_STAGE(PG8_SB(1, 0), cB + kstep, voffB); PG8_STAGE(PG8_SA(1, 0), cA + kstep, voffA); PG8_STAGE(PG8_SB(1, 1), cB + hstep + kstep, voffB);
        PG8_WAIT_V(6); PG8_BAR;
    }
    for (;;) {
        const bool has_next = S.next(ui + 1, nxt);
        const char* nA = has_next ? (const char*)g.A + (size_t)nxt.pm * tstep : cA; const char* nB = has_next ? (const char*)g.Bt + (size_t)nxt.pn * tstep : cB;
#define PG8_TPRE const bool last = (t == nt - 2); const char* a1 = cA + (size_t)(t + 1) * kstep; \
            const char* a2 = last ? nA : cA + (size_t)(t + 2) * kstep; const char* b2 = last ? nB : cB + (size_t)(t + 2) * kstep; const char* a3 = a2 + kstep; const char* b3 = b2 + kstep; \
            if (last && has_next) S.a_ready(nxt);
#define PG8_PAIR_SP2(MM) \
            PG8_LDB(B0, 0, 0); PG8_LDB(B1, 0, 1); PG8_SCHED; PG8_LDA(At, 0, 0); PG8_STAGE(PG8_SA(1, 1), a1 + hstep, voffA); \
            PG8_WAIT_V(8); PG8_WAIT_L(0); PG8_BAR; MM(0, 0, At, B0); MM(0, 1, At, B1); PG8_BAR; PG8_SCHED; \
            PG8_LDA(At, 0, 1); PG8_STAGE(PG8_SB(0, 0), b2, voffB); PG8_STAGE(PG8_SB(0, 1), b2 + hstep, voffB); PG8_STAGE(PG8_SA(0, 0), a2, voffA); \
            PG8_WAIT_V(8); PG8_WAIT_L(0); PG8_BAR; MM(1, 0, At, B0); MM(1, 1, At, B1); PG8_BAR; PG8_SCHED; \
            PG8_LDB(B0, 1, 0); PG8_LDB(B1, 1, 1); PG8_SCHED; PG8_LDA(At, 1, 0); PG8_STAGE(PG8_SA(0, 1), a2 + hstep, voffA); \
            PG8_WAIT_V(8); PG8_WAIT_L(0); PG8_BAR; MM(0, 0, At, B0); MM(0, 1, At, B1); PG8_BAR; PG8_SCHED; \
            PG8_LDA(At, 1, 1); PG8_STAGE(PG8_SB(1, 0), b3, voffB); PG8_STAGE(PG8_SB(1, 1), b3 + hstep, voffB); PG8_STAGE(PG8_SA(1, 0), a3, voffA); \
            PG8_WAIT_V(8); PG8_WAIT_L(0); PG8_BAR; MM(1, 0, At, B0); MM(1, 1, At, B1); PG8_BAR; PG8_SCHED;
#define PG8_HOOK do { if (FP8_T0 < (1 << 30)) asm volatile("s_nop 15\n\ts_nop 3" ::: "memory"); const int l2_ = lane_id_opaque(); E.mid(acc, cur, wr, wc, l2_ & 15, l2_ >> 4); } while (0)
        if constexpr (SP2 && FP8_T0 > 0 && FP8_T0 < (1 << 30)) {
            static_assert(HOOK_T < 0 || HOOK_T == FP8_T0, "the mid-K hook of a mixed GEMM sits at the bf16 / e4m3 seam");
            for (int t = 0; t < FP8_T0; t += 2) { PG8_TPRE PG8_PAIR_SP2(PG8_MMA16A) }
            if constexpr (HOOK_T >= 0) PG8_HOOK;
            for (int t = FP8_T0; t < nt; t += 2) { PG8_TPRE PG8_PAIR_SP2(PG8_MMA8) }
        } else {
        for (int t = 0; t < nt; t += 2) {
            PG8_TPRE
            if constexpr (HOOK_T >= 0) { if (t == HOOK_T) PG8_HOOK; }
            if constexpr (SP2) {
            if constexpr (FP8_T0 <= 0) { PG8_PAIR_SP2(PG8_MMA8) } else { PG8_PAIR_SP2(PG8_MMA) }
            } else {
            PG8_LDB(B0, 0, 0); PG8_SCHED; PG8_LDA(At, 0, 0); PG8_STAGE(PG8_SA(1, 1), a1 + hstep, voffA);
            PG8_WAIT_L(8); PG8_BAR; PG8_WAIT_L(0); PG8_MMA(0, 0, At, B0); PG8_BAR; PG8_SCHED;
            PG8_LDB(B1, 0, 1); PG8_STAGE(PG8_SB(0, 0), b2, voffB);
            PG8_BAR; PG8_WAIT_L(0); PG8_MMA(0, 1, At, B1); PG8_BAR;
            PG8_LDA(At, 0, 1); PG8_STAGE(PG8_SA(0, 0), a2, voffA);
            PG8_BAR; PG8_WAIT_L(0); PG8_MMA(1, 0, At, B0); PG8_BAR; PG8_SCHED;
            PG8_STAGE(PG8_SB(0, 1), b2 + hstep, voffB);
            PG8_WAIT_V(6); PG8_BAR; PG8_MMA(1, 1, At, B1); PG8_BAR;
            PG8_LDB(B0, 1, 0); PG8_SCHED; PG8_LDA(At, 1, 0); PG8_STAGE(PG8_SA(0, 1), a2 + hstep, voffA);
            PG8_WAIT_L(8); PG8_BAR; PG8_WAIT_L(0); PG8_MMA(0, 0, At, B0); PG8_BAR; PG8_SCHED;
            PG8_LDB(B1, 1, 1); PG8_STAGE(PG8_SB(1, 0), b3, voffB);
            PG8_BAR; PG8_WAIT_L(0); PG8_MMA(0, 1, At, B1); PG8_BAR;
            PG8_LDA(At, 1, 1); PG8_STAGE(PG8_SA(1, 0), a3, voffA);
            PG8_BAR; PG8_WAIT_L(0); PG8_MMA(1, 0, At, B0); PG8_BAR; PG8_SCHED;
            PG8_STAGE(PG8_SB(1, 1), b3 + hstep, voffB);
            PG8_WAIT_V(6); PG8_BAR; PG8_MMA(1, 1, At, B1); PG8_BAR;
            }
        }
        }
#undef PG8_TPRE
#undef PG8_PAIR_SP2
#undef PG8_HOOK
        if constexpr (ALIGN_EPI) { if (wr == 0) PG8_BAR; }
        if (FP8_T0 < (1 << 30)) asm volatile("s_nop 15\n\ts_nop 3" ::: "memory");
        { const int l2_ = lane_id_opaque(); E(acc, cur, wr, wc, l2_ & 15, l2_ >> 4); }
        S.done(cur);
        if (!has_next) break;
#pragma unroll
        for (int a = 0; a < 2; ++a)
#pragma unroll
            for (int b = 0; b < 2; ++b)
#pragma unroll
                for (int m = 0; m < 4; ++m)
#pragma unroll
                    for (int n = 0; n < 2; ++n) acc[a][b][m][n] = (f32x4){0.f, 0.f, 0.f, 0.f};
        cur = nxt; cA = nA; cB = nB; ++ui;
        if constexpr (ALIGN_EPI) { if (wr == 1) PG8_BAR; }
    }
    PG8_WAIT_V(0);
    if constexpr (!ALIGN_EPI) { if (wr == 0) PG8_BAR; }
    PG8_BAR;
#undef PG8_SA
#undef PG8_SB
#undef PG8_STAGE
#undef PG8_LDA
#undef PG8_LDB
#undef PG8_MMA
#undef PG8_MMA8
#undef PG8_MMA16A
#undef PG8_CAT8
#undef PG8_WAIT_V
#undef PG8_WAIT_L
#undef PG8_BAR
#undef PG8_SCHED
}
}

constexpr int NWAVES = 8;
constexpr int BATCH = 4, SEQ = 2048, DM = 2048, MTOK = BATCH * SEQ;
constexpr int NH = 16, DNOPE = 128, DROPE = 64, DQK = 192, DV = 128;
constexpr int QR = 512, KVR = 256, PLE = 256, CW = 1024, INW = 11072;
constexpr int ZN = 11264;
constexpr float EPS = 1e-6f;
constexpr float LOG2E = 1.4426950408889634f;

constexpr size_t MiB = 1u << 20;
constexpr size_t WS_CTL = 0, CTL_ZERO_BYTES = 16384;
constexpr size_t WS_COS = 1 * MiB, WS_SIN = 2 * MiB, WS_RK = 3 * MiB, WS_SSQKPE = 5 * MiB, WS_SSQ1P = 6 * MiB;
constexpr size_t WS_WIN = 8 * MiB, WS_WUQ = 52 * MiB, WS_WUKV = 55 * MiB, WS_WCAT = 57 * MiB  , WS_WOUT = 69 * MiB, WS_WPG = 77 * MiB, WS_WPP = 85 * MiB;
constexpr size_t WS_GA = 86 * MiB, WS_MAMC = 118 * MiB;
constexpr size_t WS_CONV4 = 182 * MiB, WS_ZS = 246 * MiB, WS_H = 278 * MiB;
constexpr size_t WS_Q = (MK_LAT_FUSE >= 3) ? 310 * MiB   : 182 * MiB, WS_KF = 230 * MiB, WS_VT = 278 * MiB;
constexpr size_t WS_KF8_LO = (MK_ATT_FP8 == 2) ? 40 * MiB : WS_KF, WS_KF8_HI = (MK_ATT_FP8 == 2) ? 322 * MiB : WS_KF + 12 * MiB;
constexpr int CW_CHK = 3600;
constexpr size_t WS_MERGED = 182 * MiB, WS_X1G = 214 * MiB, WS_PPROJ = 8 * MiB  , WS_X1F = 118 * MiB  ;
constexpr size_t WS_WIN8 = 32 * MiB  , WS_H8 = 310 * MiB  ;
constexpr float W8_SCALE = 32.0f;
__host__ __device__ constexpr size_t pp_quarter_off(int q) { return (q == 0 ? 24 * MiB : q == 1 ? 102 * MiB : q == 2 ? 110 * MiB : 254 * MiB) - (size_t)q * 2048 * 2048 * 2; }
constexpr size_t WS_QLAT = MK_LAT_FUSE ? 262 * MiB : 310 * MiB, WS_KVLAT = MK_LAT_FUSE ? 266 * MiB : 318 * MiB, WS_KPE = 270 * MiB  , WS_SSQL = 272 * MiB  ,
                 WS_CVG = 322 * MiB, WS_PB = 338 * MiB, WS_END = 342 * MiB;
constexpr size_t OUT_ACAT = 0;
constexpr int ACAT_LD = MK_BA_FP8 ? CW + DM / 2 : CW + DM;
constexpr float ATT8_SCALE = 16.0f;
static_assert(!MK_BA_FP8 || MK_ATT_FP8 >= 4, "MK_BA_FP8 needs the attention variant that writes e4m3 ATTG");

constexpr int CW_TMO = 0, CW_BAR = 0;

constexpr int RING_OFF = 0, RING_BYTES = 131072;
constexpr int LDS_BYTES = 163840;
constexpr int LDSCTL_OFF = LDS_BYTES - 512, MISC_OFF = LDSCTL_OFF + 320;
constexpr int EPI_RED_OFF = RING_BYTES;
static_assert(128 * 257 * 4 <= LDSCTL_OFF, "prologue transpose tile");

#define GAS __attribute__((address_space(1)))
#define LAS __attribute__((address_space(3)))
typedef unsigned short bf16;
typedef unsigned v4u __attribute__((ext_vector_type(4)));
typedef unsigned v2u __attribute__((ext_vector_type(2)));
typedef float v2f __attribute__((ext_vector_type(2)));
typedef float f32x4 __attribute__((ext_vector_type(4)));
typedef float f32x16 __attribute__((ext_vector_type(16)));
typedef short bf16x8 __attribute__((ext_vector_type(8)));
typedef short s16x4 __attribute__((ext_vector_type(4)));
typedef GAS unsigned gu32;
#define RLX_AGENT __ATOMIC_RELAXED, __HIP_MEMORY_SCOPE_AGENT
#define LDS_WAIT() asm volatile("s_waitcnt lgkmcnt(0)" ::: "memory")
#define VM_WAIT() asm volatile("s_waitcnt vmcnt(0)" ::: "memory")
__device__ __forceinline__ unsigned f2bf(float f) { unsigned u = __builtin_bit_cast(unsigned, f); return (u + 0x7fffu + ((u >> 16) & 1u)) >> 16; }
__device__ __forceinline__ unsigned pk2(float lo, float hi) { return f2bf(lo) | (f2bf(hi) << 16); }
__device__ __forceinline__ unsigned pack4_fp8(float a, float b, float c, float d) { int w = __builtin_amdgcn_cvt_pk_fp8_f32(a, b, 0, false); w = __builtin_amdgcn_cvt_pk_fp8_f32(c, d, w, true); return (unsigned)w; }
__device__ __forceinline__ float bflo(unsigned w) { return __builtin_bit_cast(float, w << 16); }
__device__ __forceinline__ float bfhi(unsigned w) { return __builtin_bit_cast(float, w & 0xffff0000u); }
__device__ __forceinline__ float sigmoidf_(float x) { return __builtin_amdgcn_rcpf(1.0f + __builtin_amdgcn_exp2f(-x * LOG2E)); }
__device__ __forceinline__ float siluf_(float x) { return x * sigmoidf_(x); }

#define XB_TMO      128
#define XB_XCNT(j)  (256  + 64 * (j))
#define XB_XSUB(j)  (1280 + 64 * (j))
#define XB_XGEN(j)  (2304 + 64 * (j))
#define XB_TOP      3328
#define XB_TOPGEN   3392
#define XCD_BAR_WORDS 3456
#define XB_DONE     3456
#ifndef MK_SELFCLEAN
#define MK_SELFCLEAN 1
#endif
static __device__ unsigned g_xbar[XCD_BAR_WORDS + 64];
#define XB_SPIN_CAP (1u << 18)
__device__ __forceinline__ unsigned xb_ld(unsigned* p)              { return __hip_atomic_load(p, __ATOMIC_RELAXED, __HIP_MEMORY_SCOPE_AGENT); }
__device__ __forceinline__ unsigned xb_add(unsigned* p, unsigned v) { return __hip_atomic_fetch_add(p, v, __ATOMIC_RELAXED, __HIP_MEMORY_SCOPE_AGENT); }
__device__ __forceinline__ unsigned xb_xcc_id() { return (unsigned)__builtin_amdgcn_s_getreg((3 << 11) | 20) & 0xFu; }
#define XB_SPIN(cond, bar) do { unsigned _sp = 0; while (cond) { __builtin_amdgcn_s_sleep(1); \
    if ((++_sp & 255u) == 0u) { if (xb_ld(&(bar)[XB_TMO])) break; if (_sp > XB_SPIN_CAP) { atomicAdd(&(bar)[XB_TMO], 1u); break; } } } } while (0)
struct XcdBarrier { unsigned* bar; unsigned x; volatile LAS unsigned* st; };
__device__ __forceinline__ XcdBarrier xcd_barrier_post(unsigned* bar, volatile LAS unsigned* st) {
    XcdBarrier b; b.bar = bar; b.x = xb_xcc_id(); b.st = st;
    if (threadIdx.x == 0) (void)xb_add(&bar[XB_XCNT(b.x)], 1u);
    return b;
}
__device__ __forceinline__ void xcd_barrier_complete(unsigned* bar, unsigned x, unsigned& nloc, unsigned& nx) {
    const unsigned G = gridDim.x * gridDim.y * gridDim.z;
    unsigned sum, cnt, mine, sp = 0u;
    for (;;) {
        sum = 0u; cnt = 0u; mine = 0u;
#pragma unroll
        for (unsigned j = 0; j < 16; ++j) { const unsigned c = xb_ld(&bar[XB_XCNT(j)]); sum += c; cnt += (c > 0u) ? 1u : 0u; mine = (j == x) ? c : mine; }
        if (sum == G) break;
        __builtin_amdgcn_s_sleep(1);
        if ((++sp & 255u) == 0u) { if (xb_ld(&bar[XB_TMO])) break; if (sp > XB_SPIN_CAP) { atomicAdd(&bar[XB_TMO], 1u); break; } }
    }
    nloc = mine > 0u ? mine : 1u; nx = cnt > 0u ? cnt : 1u;
}
__device__ __forceinline__ void xcd_barrier(const XcdBarrier& b) {
    asm volatile("s_waitcnt vmcnt(0)" ::: "memory");
    __syncthreads();
    if (threadIdx.x == 0) {
        unsigned* bar = b.bar;
        __builtin_amdgcn_s_waitcnt(0);
        unsigned nloc = b.st[0], nx = b.st[1];
        if (nloc == 0u) { xcd_barrier_complete(bar, b.x, nloc, nx); b.st[0] = nloc; b.st[1] = nx; }
        const unsigned old = xb_add(&bar[XB_XSUB(b.x)], 1u);
        const unsigned gen = old / nloc;
        if (old + 1u == (gen + 1u) * nloc) {
            __builtin_amdgcn_fence(__ATOMIC_RELEASE, "agent");
            asm volatile("s_waitcnt vmcnt(0)" ::: "memory");
            const unsigned og = xb_add(&bar[XB_TOP], 1u);
            const unsigned tg = og / nx;
            if (og + 1u == (tg + 1u) * nx) xb_add(&bar[XB_TOPGEN], 1u);
            else XB_SPIN(xb_ld(&bar[XB_TOPGEN]) == tg, bar);
            __builtin_amdgcn_fence(__ATOMIC_ACQUIRE, "agent");
            xb_add(&bar[XB_XGEN(b.x)], 1u);
            asm volatile("s_waitcnt vmcnt(0)" ::: "memory");
        } else {
            XB_SPIN(xb_ld(&bar[XB_XGEN(b.x)]) == gen, bar);
            __builtin_amdgcn_fence(__ATOMIC_ACQUIRE, "agent");
            asm volatile("s_waitcnt vmcnt(0)" ::: "memory");
        }
    }
    __syncthreads();
}

struct Args {
    const float* x; const float* p; const int* positions; const float* norm_g; const float* w_in; const float* q_lat_g; const float* kv_lat_g;
    const float* w_uq; const float* w_ukv; const float* q_norm_g; const float* k_norm_g; const float* conv_w; const float* conv_b;
    const float* w_ba; const float* w_bc; const float* w_out; const float* ple_norm_g; const float* w_pg; const float* w_pp;
    float* out; unsigned char* ws; int ph_lo, ph_hi;
};

struct Frame {
    LAS unsigned char* lds; int wave, vcu, G;
};

__device__ __forceinline__ float wave_sum(float v) {
#pragma unroll
    for (int o = 1; o < 64; o <<= 1) v += __shfl_xor(v, o);
    return v;
}

struct P0Item { const float* W; const float* kscale; bf16* WT; int K, N, dst_row0, src_col0, k0, ncols; int f8; int split; int perm; };
constexpr int P0_LD = 257;
__device__ __forceinline__ void p0_item_load(const P0Item& d, f32x4 (&v)[16], int wave, int lane) {
    if (4 * lane < d.ncols) { const float* src = d.W + (size_t)(d.k0 + 16 * wave) * d.N + d.src_col0 + 4 * lane;
#pragma unroll
        for (int i = 0; i < 16; ++i) v[i] = MK_NT_IN ? __builtin_nontemporal_load((const f32x4*)(src + (size_t)i * d.N)) : *(const f32x4*)(src + (size_t)i * d.N); }
}
__device__ __forceinline__ void p0_item_store(const P0Item& d, f32x4 (&v)[16], LAS float* tile, int wave, int lane) {
    if (4 * lane < d.ncols) {
#pragma unroll
        for (int i = 0; i < 16; ++i) { const float sc = d.kscale ? d.kscale[d.k0 + 16 * wave + i] : 1.0f; LAS float* t = tile + (16 * wave + i) * P0_LD + 4 * lane;
            t[0] = v[i][0] * sc; t[1] = v[i][1] * sc; t[2] = v[i][2] * sc; t[3] = v[i][3] * sc; } }
    __syncthreads();
    const int c = lane & 15;
#pragma unroll
    for (int jj = 0; jj < 8; ++jj) { const int n = 32 * wave + 4 * jj + (lane >> 4);
        if (n < d.ncols) { const LAS float* t = tile + (8 * c) * P0_LD + n;
            if (d.f8 && (d.perm & 2)) { const LAS float* tp = tile + (2 * c) * P0_LD + n; v2u o;
                o.x = pack4_fp8(tp[0 * P0_LD] * W8_SCALE, tp[32 * P0_LD] * W8_SCALE, tp[64 * P0_LD] * W8_SCALE, tp[96 * P0_LD] * W8_SCALE);
                o.y = pack4_fp8(tp[1 * P0_LD] * W8_SCALE, tp[33 * P0_LD] * W8_SCALE, tp[65 * P0_LD] * W8_SCALE, tp[97 * P0_LD] * W8_SCALE);
                *(GAS v2u*)((unsigned char*)d.WT + (size_t)(d.dst_row0 + n) * d.K + d.k0 + 8 * c) = o; }
            else if (d.f8) { v2u o; o.x = pack4_fp8(t[0 * P0_LD] * W8_SCALE, t[1 * P0_LD] * W8_SCALE, t[2 * P0_LD] * W8_SCALE, t[3 * P0_LD] * W8_SCALE);
                o.y = pack4_fp8(t[4 * P0_LD] * W8_SCALE, t[5 * P0_LD] * W8_SCALE, t[6 * P0_LD] * W8_SCALE, t[7 * P0_LD] * W8_SCALE);
                *(GAS v2u*)((unsigned char*)d.WT + (size_t)(d.dst_row0 + ((d.perm & 1) ? ((n & 128) | (4 * (n & 31) + ((n >> 5) & 3))) : n + (n >= 128 ? d.split : 0))) * d.K + d.k0 + 8 * c) = o;
                if (d.perm & 4) *(GAS v2u*)((unsigned char*)d.WT + (size_t)(d.dst_row0 + 128 + (n ^ 32)) * d.K + d.k0 + 8 * c) = o; }
            else { v4u o; o.x = pk2(t[0 * P0_LD], t[1 * P0_LD]); o.y = pk2(t[2 * P0_LD], t[3 * P0_LD]); o.z = pk2(t[4 * P0_LD], t[5 * P0_LD]); o.w = pk2(t[6 * P0_LD], t[7 * P0_LD]);
                *(GAS v4u*)(d.WT + (size_t)(d.dst_row0 + ((d.perm & 1) ? ((n & 128) | (4 * (n & 31) + ((n >> 5) & 3))) : n + (n >= 128 ? d.split : 0))) * d.K + d.k0 + 8 * c) = o; } } }
    __syncthreads();
}

__device__ __forceinline__ float inv_freq_f32(int i) {
    constexpr unsigned T[32] = {0x3f800000, 0x3f3ff911, 0x3f0ff59a, 0x3ed7e89b, 0x3ea1e89b, 0x3e72d425, 0x3e361887, 0x3e088d77, 0x3dcccccd, 0x3d99940d, 0x3d6655c2, 0x3d2cba15, 0x3d0186e3, 0x3cc2434f, 0x3c91ad39, 0x3c5a7bf2,
        0x3c23d70a, 0x3bf5b9b0, 0x3bb8449c, 0x3b8a2e77, 0x3b4f3e38, 0x3b1b690d, 0x3ae91528, 0x3aaec98e, 0x3a83126f, 0x3a44948c, 0x3a136a16, 0x39dd1727, 0x39a5cb60, 0x3978a815, 0x393a7753, 0x390bd472};
    return __builtin_bit_cast(float, T[i]);
}
__device__ __forceinline__ void sincos_acc(float ang, float& s, float& c) {
    const double a = (double)ang;
    const double kd = __builtin_rint(a * 0.63661977236758134308);
    double r = __builtin_fma(-kd, 1.57079632679489655800e+00, a);
    r = __builtin_fma(-kd, 6.12323399573676603587e-17, r);
    const int q = (int)((long long)kd & 3ll);
    const double r2 = r * r;
    double sp = 1.0 / 6227020800.0; sp = sp * r2 - 1.0 / 39916800.0; sp = sp * r2 + 1.0 / 362880.0; sp = sp * r2 - 1.0 / 5040.0; sp = sp * r2 + 1.0 / 120.0; sp = sp * r2 - 1.0 / 6.0; sp = sp * r2 + 1.0; sp *= r;
    double cp = -1.0 / 87178291200.0; cp = cp * r2 + 1.0 / 479001600.0; cp = cp * r2 - 1.0 / 3628800.0; cp = cp * r2 + 1.0 / 40320.0; cp = cp * r2 - 1.0 / 720.0; cp = cp * r2 + 1.0 / 24.0; cp = cp * r2 - 0.5; cp = cp * r2 + 1.0;
    const double ss = (q & 1) ? cp : sp, cc = (q & 1) ? sp : cp;
    s = (float)((q & 2) ? -ss : ss); c = (float)(((q + 1) & 2) ? -cc : cc);
}

constexpr int P1_NT16 = MK_MC_FP8 ? 16 : 24, P1_NT8 = MK_MC_FP8 ? 28 : 20;
constexpr int P0_NB_IN = (INW + 255) / 256;
constexpr int P0_I_IN = (DM / 128) * P0_NB_IN, P0_I_UQ = (QR / 128) * (NH * DQK / 256), P0_I_UKV = (KVR / 128) * (NH * 256 / 256), P0_I_BA = (DM / 128) * (DM / 256), P0_I_BC = (CW / 128) * (DM / 256),
              P0_I_OUT = (DM / 128) * (DM / 256), P0_I_PG = P0_I_OUT, P0_I_PP = (PLE / 128) * (DM / 256);
constexpr int P0_NITEMS = P0_I_IN + P0_I_UQ + P0_I_UKV + P0_I_BA + P0_I_BC + P0_I_OUT + P0_I_PG + P0_I_PP;
constexpr int P0_EARLY = (P0_I_IN + P0_I_UQ + P0_I_UKV) / 256 * 256;
constexpr int P0_IN_P3 = 128;
__device__ __forceinline__ P0Item p0_decode(const Args& A, int it) {
    unsigned char* ws = A.ws; P0Item d; int r = it;
    if (r < P0_I_IN) { const int kb = r / P0_NB_IN, nb = r % P0_NB_IN;
        d = P0Item{A.w_in, nullptr, (bf16*)(ws + WS_WIN8), DM, INW, 0, 0, 128 * kb, 256, 1};
        if (nb < 3) { d.src_col0 = 256 * nb; d.dst_row0 = 256 * nb; }
        else if (nb == 3) { d.src_col0 = 768; d.dst_row0 = 768; d.ncols = 64; if (MK_LAT_FUSE >= 2) d.perm = 4; }
        else { const int q = nb - 4; d.src_col0 = 832 + 256 * q;
            if (q < 8) { d.dst_row0 = 1024 + 256 * q; if (MK_ATT_PERM && MK_GA_FP8 && MK_ATT_FP8 == 5) d.perm = 1; }
            else if (q < 24) { d.WT = (bf16*)(ws + WS_WIN); d.f8 = 0;
                if (MK_CONV_FUSE) { const int kind = (q - 8) >> 2, sb = (q - 8) & 3;
                    const int base = (kind == 1 || kind == 2) ? 0 : 8, half = (kind == 2 || kind == 3) ? 1 : 0; d.dst_row0 = (base + 2 * sb) * 256 + half * 128; d.split = 128; }
                else d.dst_row0 = 256 * (q - 8); }
            else if (MK_GATE_FUSE && MK_MC_FP8) { const int kind = (q - 24) >> 3, sb = (q - 24) & 7; d.dst_row0 = (12 + 2 * sb) * 256 + kind * 128; d.split = 128; }
            else if (q < 32) d.dst_row0 = 3072 + 256 * (q - 24);
            else if (MK_MC_FP8) d.dst_row0 = 5120 + 256 * (q - 32);
            else { d.WT = (bf16*)(ws + WS_WIN); d.f8 = 0; d.dst_row0 = 4096 + 256 * (q - 32); } }
        return d; } r -= P0_I_IN;
    if (r < P0_I_UQ) { const int nblk = NH * DQK / 256, kb = r / nblk, nb = r % nblk; d = P0Item{A.w_uq, A.q_lat_g, (bf16*)(ws + WS_WUQ), QR, NH * DQK, 256 * nb, 256 * nb, 128 * kb, 256, 1}; return d; } r -= P0_I_UQ;
    if (r < P0_I_UKV) { const int nblk = NH * 256 / 256, kb = r / nblk, nb = r % nblk; d = P0Item{A.w_ukv, A.kv_lat_g, (bf16*)(ws + WS_WUKV), KVR, NH * 256, 256 * nb, 256 * nb, 128 * kb, 256, 0}; return d; } r -= P0_I_UKV;
    const int nblk = DM / 256;
    if (r < P0_I_BA) { const int kb = r / nblk, nb = r % nblk; d = MK_BA_FP8 ? P0Item{A.w_ba, nullptr, (bf16*)(ws + WS_WCAT) + CW, 2 * ACAT_LD, DM, 256 * nb, 256 * nb, 128 * kb, 256, 1, 0, (MK_ATT_PERM && MK_GA_FP8 && MK_ATT_FP8 == 5) ? 2 : 0}
                                            : P0Item{A.w_ba, nullptr, (bf16*)(ws + WS_WCAT) + CW, ACAT_LD, DM, 256 * nb, 256 * nb, 128 * kb, 256, 0}; return d; } r -= P0_I_BA;
    if (r < P0_I_BC) { const int kb = r / nblk, nb = r % nblk; d = P0Item{A.w_bc, nullptr, (bf16*)(ws + WS_WCAT), ACAT_LD, DM, 256 * nb, 256 * nb, 128 * kb, 256, 0}; return d; } r -= P0_I_BC;
    if (r < P0_I_OUT) { const int kb = r / nblk, nb = r % nblk; d = P0Item{A.w_out, nullptr, (bf16*)(ws + WS_WOUT), DM, DM, 256 * nb, 256 * nb, 128 * kb, 256, 0}; return d; } r -= P0_I_OUT;
    if (r < P0_I_PP) { const int kb = r / nblk, nb = r % nblk; d = P0Item{A.w_pp, nullptr, (bf16*)(ws + WS_WPP), PLE, DM, 256 * nb, 256 * nb, 128 * kb, 256, 0}; return d; } r -= P0_I_PP;
    { const int kb = r / nblk, nb = r % nblk; d = P0Item{A.w_pg, A.ple_norm_g, (bf16*)(ws + WS_WPG), DM, DM, 256 * nb, 256 * nb, 128 * kb, 256, 0}; return d; }
}
__device__ __forceinline__ void p0_items(const Args& A, LAS float* tile, int wave, int lane, int wgl, int nwg, int first, int last) {
    f32x4 va[16], vb[16]; P0Item da, db; int it = first + wgl;
    if (it < last) { da = p0_decode(A, it); p0_item_load(da, va, wave, lane); }
    while (it < last) {
        int itn = it + nwg;
        if (itn < last) { db = p0_decode(A, itn); p0_item_load(db, vb, wave, lane); }
        p0_item_store(da, va, tile, wave, lane);
        it = itn; if (it >= last) break;
        itn = it + nwg;
        if (itn < last) { da = p0_decode(A, itn); p0_item_load(da, va, wave, lane); }
        p0_item_store(db, vb, tile, wave, lane);
        it = itn;
    }
}
__device__ __forceinline__ void p0_prologue(const Frame& F, const Args& A) {
    unsigned char* ws = A.ws; const int lane = lane_id_opaque();
    const int gw = F.vcu * NWAVES + F.wave, NGW = F.G * NWAVES;
    p0_items(A, (LAS float*)(F.lds + RING_OFF), F.wave, lane, F.vcu, F.G, 0, P0_EARLY);
    { const int gt = gw * 64 + lane, NGT = NGW * 64; GAS v4u* z = (GAS v4u*)(ws + WS_WIN8 + (size_t)832 * DM);
      if (MK_LAT_FUSE >= 2) { for (int i = gt; i < 128 * DM / 16; i += NGT) { const int j = i < 64 * DM / 16 ? i : i + 64 * DM / 16; z[j] = (v4u){0u, 0u, 0u, 0u}; } }
      else for (int i = gt; i < 192 * DM / 16; i += NGT) z[i] = (v4u){0u, 0u, 0u, 0u}; }
    { bf16* H = (bf16*)(ws + WS_H); const GAS f32x4* gr = (const GAS f32x4*)A.norm_g + lane;
      for (int m0 = gw; m0 < MTOK; m0 += 4 * NGW) {
        f32x4 v[4][8];
#pragma unroll
        for (int q = 0; q < 4; ++q) { const int m = m0 + q * NGW; if (m < MTOK) { const GAS f32x4* xr = (const GAS f32x4*)(A.x + (size_t)m * DM) + lane;
#pragma unroll
            for (int j = 0; j < 8; ++j) v[q][j] = MK_NT_IN ? __builtin_nontemporal_load(&xr[64 * j]) : xr[64 * j]; } }
#pragma unroll
        for (int q = 0; q < 4; ++q) { const int m = m0 + q * NGW; if (m < MTOK) { float s = 0.f;
#pragma unroll
            for (int j = 0; j < 8; ++j) s += (v[q][j].x * v[q][j].x + v[q][j].y * v[q][j].y) + (v[q][j].z * v[q][j].z + v[q][j].w * v[q][j].w);
            const float rs = 1.0f / sqrtf(wave_sum(s) * (1.f / DM) + EPS);
            GAS v2u* o8 = (GAS v2u*)(H + (size_t)m * DM) + lane; GAS unsigned* o4 = (GAS unsigned*)(ws + WS_H8 + (size_t)m * DM) + lane;
#pragma unroll
            for (int j = 0; j < 8; ++j) { const f32x4 g = gr[64 * j]; const float h0 = v[q][j].x * rs * g.x, h1 = v[q][j].y * rs * g.y, h2 = v[q][j].z * rs * g.z, h3 = v[q][j].w * rs * g.w;
                v2u w; w.x = pk2(h0, h1); w.y = pk2(h2, h3); o8[64 * j] = w; o4[64 * j] = pack4_fp8(h0, h1, h2, h3); } } }
      } }
    { float* COS = (float*)(ws + WS_COS); float* SIN = (float*)(ws + WS_SIN); const int gt = gw * 64 + lane, NGT = NGW * 64;
      for (int i = gt; i < MTOK * 32; i += NGT) { const int t = i >> 5, f = i & 31; const float ang = (float)A.positions[t] * inv_freq_f32(f); float s, c; sincos_acc(ang, s, c); COS[i] = c; SIN[i] = s; } }
    { bf16* PB = (bf16*)(ws + WS_PB); const int gt = gw * 64 + lane, NGT = NGW * 64;
      for (int i = gt; i < MTOK * PLE / 8; i += NGT) { const f32x4 a = (MK_NT_IN >= 2 ? __builtin_nontemporal_load(&((const GAS f32x4*)A.p)[2 * i]) : *(&((const GAS f32x4*)A.p)[2 * i])), b = (MK_NT_IN >= 2 ? __builtin_nontemporal_load(&((const GAS f32x4*)A.p)[2 * i + 1]) : *(&((const GAS f32x4*)A.p)[2 * i + 1]));
        v4u o; o.x = pk2(a.x, a.y); o.y = pk2(a.z, a.w); o.z = pk2(b.x, b.y); o.w = pk2(b.z, b.w); ((GAS v4u*)PB)[i] = o; } }
}

using pg8::Unit;
#define EPI_ROWS_BEGIN _Pragma("unroll") for (int ai = 0; ai < 2; ++ai) _Pragma("unroll") for (int m = 0; m < 4; ++m) { const int row = u.pm * 256 + ai * 128 + wr * 64 + m * 16 + fr;
#define EPI_ROWS_END }
__device__ __forceinline__ v4u pack8(const f32x4 a, const f32x4 b) { v4u w; w.x = pg8::cvt_pk_bf16(a[0], a[1]); w.y = pg8::cvt_pk_bf16(a[2], a[3]); w.z = pg8::cvt_pk_bf16(b[0], b[1]); w.w = pg8::cvt_pk_bf16(b[2], b[3]); return w; }
__device__ __forceinline__ void unpack8_f8(const v2u w, float (&f)[8]) {
#pragma unroll
    for (int i = 0; i < 2; ++i) { const int d = (int)(i ? w.y : w.x); f[4 * i] = __builtin_amdgcn_cvt_f32_fp8(d, 0); f[4 * i + 1] = __builtin_amdgcn_cvt_f32_fp8(d, 1); f[4 * i + 2] = __builtin_amdgcn_cvt_f32_fp8(d, 2); f[4 * i + 3] = __builtin_amdgcn_cvt_f32_fp8(d, 3); }
}
__device__ __forceinline__ void unpack8(const v4u w, float (&f)[8]) { f[0] = bflo(w.x); f[1] = bfhi(w.x); f[2] = bflo(w.y); f[3] = bfhi(w.y); f[4] = bflo(w.z); f[5] = bfhi(w.z); f[6] = bflo(w.w); f[7] = bfhi(w.w); }

struct EpiZ {
    static constexpr bool PERM = true;
    unsigned char* ws; int f8; const float* gk;
    __device__ __forceinline__ void operator()(const f32x4 (&acc)[2][2][4][2], const Unit& u, int wr, int wc, int fr, int fq) const {
        const int cl = wc * 32 + 8 * fq;
        if (MK_LAT_FUSE && f8 && u.pn < 4) {
            float* SSQL = (float*)(ws + WS_SSQL);
            EPI_ROWS_BEGIN
                float ss = 0.f;
#pragma unroll
                for (int bj = 0; bj < 2; ++bj) { const f32x4 a = acc[ai][bj][m][0], c = acc[ai][bj][m][1];
                    if (!(MK_LAT_FUSE >= 2 && u.pn == 3 && bj == 1)) ss += (a[0] * a[0] + a[1] * a[1]) + (a[2] * a[2] + a[3] * a[3]) + (c[0] * c[0] + c[1] * c[1]) + (c[2] * c[2] + c[3] * c[3]);
                    if (u.pn < 2) { v2u o; o.x = pack4_fp8(a[0], a[1], a[2], a[3]); o.y = pack4_fp8(c[0], c[1], c[2], c[3]); *(v2u*)(ws + WS_QLAT + (size_t)row * QR + u.pn * 256 + cl + bj * 128) = o; }
                    else if (u.pn == 2) *(v4u*)((bf16*)(ws + WS_KVLAT) + (size_t)row * KVR + cl + bj * 128) = pack8(a, c);
                    else if (MK_LAT_FUSE < 2 && bj == 0 && wc < 2) { float* kp = (float*)(ws + WS_KPE) + (size_t)row * 64 + cl; *(f32x4*)kp = a; *(f32x4*)(kp + 4) = c; } }
                if (MK_LAT_FUSE >= 2 && u.pn == 3 && wc < 2) {
                    const int i0_ = cl, f0_ = 8 * fq;
                    const float* cp = (const float*)(ws + WS_COS) + (size_t)row * 32 + f0_; const float* sp = (const float*)(ws + WS_SIN) + (size_t)row * 32 + f0_;
                    const f32x4 cA = *(const f32x4*)cp, cB = *(const f32x4*)(cp + 4), sA = *(const f32x4*)sp, sB = *(const f32x4*)(sp + 4);
                    const f32x4 gA = *(const f32x4*)(gk + DNOPE + i0_), gB = *(const f32x4*)(gk + DNOPE + i0_ + 4), hA = *(const f32x4*)(gk + DNOPE + (i0_ ^ 32)), hB = *(const f32x4*)(gk + DNOPE + (i0_ ^ 32) + 4);
                    const f32x4 vA = acc[ai][0][m][0] * gA, vB = acc[ai][0][m][1] * gB, oA = acc[ai][1][m][0] * hA, oB = acc[ai][1][m][1] * hB;
                    const float sg = (wc == 0) ? -1.f : 1.f;
                    float* rk = (float*)(ws + WS_RK) + (size_t)row * 64 + i0_;
                    *(f32x4*)rk = vA * cA + oA * sA * sg; *(f32x4*)(rk + 4) = vB * cB + oB * sB * sg; }
                ss += __shfl_xor(ss, 16); ss += __shfl_xor(ss, 32);
                if (fq == 0) SSQL[(size_t)row * 16 + u.pn * 4 + wc] = ss;
            EPI_ROWS_END
        } else
        if (f8 && u.pn < 4) {
            if (MK_ZS_BF16) { bf16* ZSb = (bf16*)(ws + WS_ZS);
            EPI_ROWS_BEGIN  bf16* rp = ZSb + (size_t)row * 1024 + u.pn * 256 + cl;
#pragma unroll
                for (int bj = 0; bj < 2; ++bj) *(v4u*)(rp + bj * 128) = pack8(acc[ai][bj][m][0], acc[ai][bj][m][1]);  EPI_ROWS_END }
            else {
            float* ZS = (float*)(ws + WS_ZS);
            EPI_ROWS_BEGIN  float* rp = ZS + (size_t)row * 1024 + u.pn * 256 + cl;
#pragma unroll
                for (int bj = 0; bj < 2; ++bj) { *(f32x4*)(rp + bj * 128) = acc[ai][bj][m][0]; *(f32x4*)(rp + bj * 128 + 4) = acc[ai][bj][m][1]; }  EPI_ROWS_END }
        } else {
            size_t boff; int ld, c0;
            if (MK_GA_FP8 && MK_ATT_FP8 == 5 && f8 && u.pn >= 4 && u.pn < 12) {
                unsigned char* g8 = ws + WS_GA + (u.pn - 4) * 256 + cl;
                EPI_ROWS_BEGIN
#pragma unroll
                    for (int bj = 0; bj < 2; ++bj) { v2u o;
                        { f32x4 a0 = acc[ai][bj][m][0]; asm volatile("" : "+v"(a0));
                          o.x = pack4_fp8(siluf_(a0[0]) * 16.f, siluf_(a0[1]) * 16.f, siluf_(a0[2]) * 16.f, siluf_(a0[3]) * 16.f); }
                        { f32x4 a1 = acc[ai][bj][m][1]; asm volatile("" : "+v"(a1)); o.y = pack4_fp8(siluf_(a1[0]) * 16.f, siluf_(a1[1]) * 16.f, siluf_(a1[2]) * 16.f, siluf_(a1[3]) * 16.f); }
                        *(v2u*)(g8 + (size_t)row * 2048 + bj * 128) = o; }
                EPI_ROWS_END
                return; }
            if (MK_GATE_FUSE && MK_MC_FP8 && f8 && u.pn >= 12) {
                bf16* base2 = (bf16*)(ws + WS_MAMC) + (u.pn - 12) * 128 + cl;
                EPI_ROWS_BEGIN  f32x4 s0, s1, r0, r1; const f32x4 a0 = acc[ai][0][m][0], a1 = acc[ai][0][m][1], c0_ = acc[ai][1][m][0], c1_ = acc[ai][1][m][1];
#pragma unroll
                    for (int j = 0; j < 4; ++j) { const float ea0 = 1.0f + __builtin_amdgcn_exp2f(-a0[j] * LOG2E), ea1 = 1.0f + __builtin_amdgcn_exp2f(-a1[j] * LOG2E);
                        s0[j] = __builtin_amdgcn_rcpf(ea0); s1[j] = __builtin_amdgcn_rcpf(ea1);
                        r0[j] = ea0 * __builtin_amdgcn_rcpf(1.0f + __builtin_amdgcn_exp2f(-c0_[j] * LOG2E)); r1[j] = ea1 * __builtin_amdgcn_rcpf(1.0f + __builtin_amdgcn_exp2f(-c1_[j] * LOG2E)); }
                    *(v4u*)(base2 + (size_t)row * 4096) = pack8(s0, s1); *(v4u*)(base2 + (size_t)row * 4096 + 2048) = pack8(r0, r1);  EPI_ROWS_END
                return; }
            if (f8) { if (u.pn < 12) { boff = WS_GA; ld = 2048; c0 = (u.pn - 4) * 256; } else { boff = WS_MAMC; ld = 4096; c0 = (u.pn - 12) * 256; } }
            else { if (u.pn < 16) { boff = WS_CONV4; ld = 4096; c0 = u.pn * 256; } else { boff = WS_MAMC; ld = 4096; c0 = 2048 + (u.pn - 16) * 256; } }
            if (MK_CONV_FUSE && !f8 && u.pn < 16) {
                bf16* base2 = (bf16*)(ws + WS_CONV4) + (u.pn < 8 ? 0 : 1024) + (u.pn & 7) * 128 + cl; const bool isbg = u.pn >= 8;
                if (isbg) { EPI_ROWS_BEGIN  f32x4 p0 = acc[ai][0][m][0], p1 = acc[ai][0][m][1]; const f32x4 q0 = acc[ai][1][m][0], q1 = acc[ai][1][m][1];
#pragma unroll
                    for (int j = 0; j < 4; ++j) { p0[j] *= siluf_(q0[j]); p1[j] *= siluf_(q1[j]); }
                    *(v4u*)(base2 + (size_t)row * 2048) = pack8(p0, p1);  EPI_ROWS_END }
                else { EPI_ROWS_BEGIN  *(v4u*)(base2 + (size_t)row * 2048) = pack8(acc[ai][0][m][0] * acc[ai][1][m][0], acc[ai][0][m][1] * acc[ai][1][m][1]);  EPI_ROWS_END }
                return; }
            bf16* base = (bf16*)(ws + boff);
            EPI_ROWS_BEGIN  bf16* rp = base + (size_t)row * ld + c0 + cl;
#pragma unroll
                for (int bj = 0; bj < 2; ++bj) *(v4u*)(rp + bj * 128) = pack8(acc[ai][bj][m][0], acc[ai][bj][m][1]);  EPI_ROWS_END
        }
    }
};
struct EpiBf16 {
    static constexpr bool PERM = true;
    bf16* O; int ldc;
    __device__ __forceinline__ void operator()(const f32x4 (&acc)[2][2][4][2], const Unit& u, int wr, int wc, int fr, int fq) const {
        const int cl = u.pn * 256 + wc * 32 + 8 * fq;
        EPI_ROWS_BEGIN  bf16* rp = O + (size_t)row * ldc + cl;
#pragma unroll
            for (int bj = 0; bj < 2; ++bj) *(v4u*)(rp + bj * 128) = pack8(acc[ai][bj][m][0], acc[ai][bj][m][1]);  EPI_ROWS_END
    }
};
struct EpiPP {
    static constexpr bool PERM = true;
    unsigned char* ws;
    __device__ __forceinline__ void operator()(const f32x4 (&acc)[2][2][4][2], const Unit& u, int wr, int wc, int fr, int fq) const {
        const int cl = u.pn * 256 + wc * 32 + 8 * fq; bf16* O = (bf16*)(ws + (MK_PP_SPLIT ? pp_quarter_off(u.pm >> 3) : WS_PPROJ));
        EPI_ROWS_BEGIN  bf16* rp = O + (size_t)row * DM + cl;
#pragma unroll
            for (int bj = 0; bj < 2; ++bj) *(v4u*)(rp + bj * 128) = pack8(acc[ai][bj][m][0], acc[ai][bj][m][1]);  EPI_ROWS_END
    }
};
struct EpiF8 {
    static constexpr bool PERM = true;
    unsigned char* O; int ldc; float sc0; const float* SSQL;
    __device__ __forceinline__ void operator()(const f32x4 (&acc)[2][2][4][2], const Unit& u, int wr, int wc, int fr, int fq) const {
        const int cl = u.pn * 256 + wc * 32 + 8 * fq;
        EPI_ROWS_BEGIN  unsigned char* rp = O + (size_t)row * ldc + cl;
            float sc = sc0;
            if (SSQL) { const v2f p2 = *(const v2f*)(SSQL + (size_t)row * 16 + 2 * fq); float ss = p2.x + p2.y; ss += __shfl_xor(ss, 16); ss += __shfl_xor(ss, 32); sc = sc0 / sqrtf(ss * (1.f / QR) + EPS); }
#pragma unroll
            for (int bj = 0; bj < 2; ++bj) { const f32x4 a = acc[ai][bj][m][0] * sc, c = acc[ai][bj][m][1] * sc; v2u o; o.x = pack4_fp8(a[0], a[1], a[2], a[3]); o.y = pack4_fp8(c[0], c[1], c[2], c[3]); *(v2u*)(rp + bj * 128) = o; }  EPI_ROWS_END
    }
};
__device__ __forceinline__ int v_st(int k, int c) { const int kk = (k & ~0xC) | ((k & 4) << 1) | ((k & 8) >> 1); return ((kk >> 3) * 4 + (c >> 5)) * 512 + ((kk & 7) * 32 + (c & 31)) * 2; }
struct EpiKV {
    static constexpr bool PERM = true;
    bf16* KF; bf16* VT; const float* RK; const float* SSQKPE; const float* gk; LAS float* red; unsigned char* KF8lo; unsigned char* KF8hi; const float* SSQL;
    mutable int par;
    __device__ __forceinline__ void operator()(const f32x4 (&acc)[2][2][4][2], const Unit& u, int wr, int wc, int fr, int fq) const {
        const int h = u.pn; LAS float* P = red + par * 1024; LAS float* Rk = red + 6144 + par * 256; par ^= 1;
        LAS unsigned char* vstage = (LAS unsigned char*)red + 8192 + (wr * 4 + wc) * 2048;
#define EPIKV_RKV(ai_, m_) ({ float r_ = 1.f; if (MK_LAT_FUSE) { float sl_ = SSQL[(size_t)(u.pm * 256 + (ai_) * 128 + wr * 64 + (m_) * 16 + fr) * 16 + 8 + fq]; sl_ += __shfl_xor(sl_, 16); sl_ += __shfl_xor(sl_, 32); r_ = 1.0f / sqrtf(sl_ * (1.f / KVR) + EPS); } r_; })
#pragma unroll
        for (int ai = 0; ai < 2; ++ai)
#pragma unroll
            for (int m = 0; m < 4; ++m) { const f32x4 a = acc[ai][0][m][0], c = acc[ai][0][m][1];
                float ss = (a[0] * a[0] + a[1] * a[1]) + (a[2] * a[2] + a[3] * a[3]) + (c[0] * c[0] + c[1] * c[1]) + (c[2] * c[2] + c[3] * c[3]);
                { const float r_ = EPIKV_RKV(ai, m); ss *= r_ * r_; if (MK_LAT_FUSE && fq == 0 && wc == 0) Rk[ai * 128 + wr * 64 + m * 16 + fr] = r_; }
                ss += __shfl_xor(ss, 16); ss += __shfl_xor(ss, 32);
                if (fq == 0) P[(ai * 128 + wr * 64 + m * 16 + fr) * 4 + wc] = ss; }
        asm volatile("s_waitcnt lgkmcnt(0)\n\ts_barrier" ::: "memory");
        const f32x4 g0 = *(const f32x4*)(gk + 32 * wc + 8 * fq), g1 = *(const f32x4*)(gk + 32 * wc + 8 * fq + 4);
#pragma unroll
        for (int ai = 0; ai < 2; ++ai) {
            float sk[4]; f32x4 rk4[4];
#pragma unroll
            for (int m = 0; m < 4; ++m) { const int row = u.pm * 256 + ai * 128 + wr * 64 + m * 16 + fr; if (MK_LAT_FUSE >= 2) { const v2f s2_ = *(const v2f*)(SSQL + (size_t)row * 16 + 12); sk[m] = s2_.x + s2_.y; } else sk[m] = SSQKPE[row]; rk4[m] = *(const f32x4*)(RK + (size_t)row * 64 + 16 * wc + 4 * fq); }
#pragma unroll
            for (int m = 0; m < 4; ++m) { const int row = u.pm * 256 + ai * 128 + wr * 64 + m * 16 + fr;
                const int b = row >> 11, s = row & 2047, tile = s >> 6, kr = s & 63; const size_t tb = (size_t)((b * NH + h) * 32 + tile);
                const f32x4 p4 = *(const LAS f32x4*)(P + (ai * 128 + wr * 64 + m * 16 + fr) * 4);
                const float rkv_m = MK_LAT_FUSE ? Rk[ai * 128 + wr * 64 + m * 16 + fr] : 1.f;
                const float rs = 1.0f / sqrtf((((p4[0] + p4[1]) + (p4[2] + p4[3])) + sk[m]) * (1.f / DQK) + EPS);
                const f32x4 kn0 = acc[ai][0][m][0] * g0 * (rs * rkv_m), kn1 = acc[ai][0][m][1] * g1 * (rs * rkv_m); const f32x4 r4 = rk4[m] * rs;
                if (MK_ATT_FP8 == 0 || MK_ATT_FP8 == 2) {
                    *(v4u*)(KF + tb * 12288 + (4 * wc + fq) * 512 + kr * 8) = pack8(kn0, kn1);
                    v2u w; w.x = pg8::cvt_pk_bf16(r4[0], r4[1]); w.y = pg8::cvt_pk_bf16(r4[2], r4[3]);
                    *(v2u*)(KF + tb * 12288 + (16 + 2 * wc + (fq >> 1)) * 512 + kr * 8 + (fq & 1) * 4) = w; }
                if (MK_ATT_FP8 != 0) {
                    unsigned char* k8 = (b < 2 ? KF8lo : KF8hi) + (size_t)(((b & 1) * NH + h) * 32 + tile) * 12288 + kr * 16;
                    v2u w8; w8.x = pack4_fp8(kn0[0], kn0[1], kn0[2], kn0[3]); w8.y = pack4_fp8(kn1[0], kn1[1], kn1[2], kn1[3]);
                    *(v2u*)(k8 + (2 * wc + (fq >> 1)) * 1024 + 8 * (fq & 1)) = w8;
                    *(unsigned*)(k8 + ((4 + (wc & 1)) * 2 + (wc >> 1)) * 1024 + 4 * fq) = pack4_fp8(r4[0], r4[1], r4[2], r4[3]); }
                if (MK_ATT_FP8 < 3) *(v4u*)((unsigned char*)VT + tb * 16384 + v_st(kr, 32 * wc + 8 * fq)) = pack8(acc[ai][1][m][0], acc[ai][1][m][1]);
                else {
                    const f32x4 v0 = acc[ai][1][m][0] * rkv_m, v1 = acc[ai][1][m][1] * rkv_m;
                    const unsigned w0 = pack4_fp8(v0[0], v0[1], v0[2], v0[3]), w1 = pack4_fp8(v1[0], v1[1], v1[2], v1[3]);
                    LAS unsigned char* vp = vstage + ((((kr >> 2) & 1) * 2 + (kr >> 5)) * 32 + 8 * fq) * 16 + (((kr >> 3) & 3) * 4 + (kr & 3));
                    vp[0] = (unsigned char)w0; vp[16] = (unsigned char)(w0 >> 8); vp[32] = (unsigned char)(w0 >> 16); vp[48] = (unsigned char)(w0 >> 24);
                    vp[64] = (unsigned char)w1; vp[80] = (unsigned char)(w1 >> 8); vp[96] = (unsigned char)(w1 >> 16); vp[112] = (unsigned char)(w1 >> 24); } }
            if (MK_ATT_FP8 >= 3) {
                const int row0 = u.pm * 256 + ai * 128 + wr * 64; const size_t tb0 = (size_t)(((row0 >> 11) * NH + h) * 32 + ((row0 & 2047) >> 6));
                asm volatile("s_waitcnt lgkmcnt(0)" ::: "memory");
                const int l2_ = (fq << 4) | fr; const v4u x0 = *(const LAS v4u*)(vstage + 32 * l2_), x1 = *(const LAS v4u*)(vstage + 32 * l2_ + 16);
                unsigned char* gp = (unsigned char*)VT + tb0 * 8192 + wc * 2048 + 32 * l2_;
                *(v4u*)gp = x0; *(v4u*)(gp + 16) = x1;
                asm volatile("s_waitcnt lgkmcnt(0)" ::: "memory"); }
        }
    }
};
#undef EPIKV_RKV
#define EPI_PAIR_BEGIN _Pragma("unroll") for (int gp = 0; gp < 4; ++gp) {
#define EPI_PAIR_END }
#define EPI_ROW_OF(g) (u.pm * 256 + (((gp) * 2 + (g)) >> 2) * 128 + wr * 64 + (((gp) * 2 + (g)) & 3) * 16 + fr)
#define EPI_ACC(g, bj, n) acc[((gp) * 2 + (g)) >> 2][bj][((gp) * 2 + (g)) & 3][n]
struct EpiMerge2 {
    static constexpr bool PERM = true;
    const bf16* MAMC; bf16* MG;
    __device__ __forceinline__ void mid(f32x4 (&acc)[2][2][4][2], const Unit& u, int wr, int wc, int fr, int fq) const {
        const int cl = u.pn * 256 + wc * 32 + 8 * fq; const bf16* __restrict__ mamc = MAMC;
        EPI_PAIR_BEGIN
            v4u av[2][2], cv[2][2];
#pragma unroll
            for (int g = 0; g < 2; ++g)
#pragma unroll
                for (int bj = 0; bj < 2; ++bj) { const bf16* p = mamc + (size_t)EPI_ROW_OF(g) * 4096 + cl + bj * 128; if (!(MK_GATE_FUSE && MK_MC_FP8)) av[g][bj] = *(const v4u*)p; cv[g][bj] = (MK_NT_IN >= 2 ? __builtin_nontemporal_load((const v4u*)(p + 2048)) : *((const v4u*)(p + 2048))); }
#pragma unroll
            for (int g = 0; g < 2; ++g)
#pragma unroll
                for (int bj = 0; bj < 2; ++bj) { float ga[8], gc[8]; unpack8(cv[g][bj], gc);
                    if (MK_GATE_FUSE && MK_MC_FP8) {
#pragma unroll
                        for (int j = 0; j < 4; ++j) { EPI_ACC(g, bj, 0)[j] *= gc[j]; EPI_ACC(g, bj, 1)[j] *= gc[4 + j]; }
                        continue; }
                    unpack8(av[g][bj], ga);
#pragma unroll
                    for (int j = 0; j < 4; ++j) {
                        EPI_ACC(g, bj, 0)[j] *= (1.0f + __builtin_amdgcn_exp2f(-ga[j] * LOG2E)) * __builtin_amdgcn_rcpf(1.0f + __builtin_amdgcn_exp2f(-gc[j] * LOG2E));
                        EPI_ACC(g, bj, 1)[j] *= (1.0f + __builtin_amdgcn_exp2f(-ga[4 + j] * LOG2E)) * __builtin_amdgcn_rcpf(1.0f + __builtin_amdgcn_exp2f(-gc[4 + j] * LOG2E)); } }
        EPI_PAIR_END
    }
    __device__ __forceinline__ void operator()(const f32x4 (&acc)[2][2][4][2], const Unit& u, int wr, int wc, int fr, int fq) const {
        const int cl = u.pn * 256 + wc * 32 + 8 * fq; const bf16* __restrict__ mamc = MAMC; bf16* __restrict__ mg = MG;
        EPI_PAIR_BEGIN
            v4u gv[2][2];
#pragma unroll
            for (int g = 0; g < 2; ++g)
#pragma unroll
                for (int bj = 0; bj < 2; ++bj) gv[g][bj] = (MK_NT_IN >= 2 ? __builtin_nontemporal_load((const v4u*)(mamc + (size_t)EPI_ROW_OF(g) * 4096 + cl + bj * 128)) : *((const v4u*)(mamc + (size_t)EPI_ROW_OF(g) * 4096 + cl + bj * 128)));
#pragma unroll
            for (int g = 0; g < 2; ++g)
#pragma unroll
                for (int bj = 0; bj < 2; ++bj) { float gg[8]; unpack8(gv[g][bj], gg); f32x4 a = EPI_ACC(g, bj, 0), c = EPI_ACC(g, bj, 1);
#pragma unroll
                    for (int j = 0; j < 4; ++j) { a[j] *= (MK_GATE_FUSE && MK_MC_FP8) ? gg[j] : sigmoidf_(gg[j]); c[j] *= (MK_GATE_FUSE && MK_MC_FP8) ? gg[4 + j] : sigmoidf_(gg[4 + j]); }
                    *(v4u*)(mg + (size_t)EPI_ROW_OF(g) * 2048 + cl + bj * 128) = pack8(a, c); }
        EPI_PAIR_END
    }
};
struct EpiX1 {
    static constexpr bool PERM = true;
    const float* X; float* X1F; bf16* X1G; float* SSQ1P;
    __device__ __forceinline__ void operator()(const f32x4 (&acc)[2][2][4][2], const Unit& u, int wr, int wc, int fr, int fq) const {
        const int cl = u.pn * 256 + wc * 32 + 8 * fq; const float* __restrict__ x = X; float* __restrict__ x1f = X1F; bf16* __restrict__ x1g = X1G;
        EPI_PAIR_BEGIN
            f32x4 xv[2][2][2];
#pragma unroll
            for (int g = 0; g < 2; ++g)
#pragma unroll
                for (int bj = 0; bj < 2; ++bj) { const size_t off = (size_t)EPI_ROW_OF(g) * 2048 + cl + bj * 128; xv[g][bj][0] = (MK_NT_IN >= 2 ? __builtin_nontemporal_load((const f32x4*)(x + off)) : *((const f32x4*)(x + off))); xv[g][bj][1] = (MK_NT_IN >= 2 ? __builtin_nontemporal_load((const f32x4*)(x + off + 4)) : *((const f32x4*)(x + off + 4))); }
#pragma unroll
            for (int g = 0; g < 2; ++g) { float ss = 0.f; const int row = EPI_ROW_OF(g);
#pragma unroll
                for (int bj = 0; bj < 2; ++bj) { const size_t off = (size_t)row * 2048 + cl + bj * 128;
                    const f32x4 a = xv[g][bj][0] + EPI_ACC(g, bj, 0), c = xv[g][bj][1] + EPI_ACC(g, bj, 1);
                    if (!MK_X1_BF16) { *(f32x4*)(x1f + off) = a; *(f32x4*)(x1f + off + 4) = c; } *(v4u*)(x1g + off) = pack8(a, c);
                    ss += (a[0] * a[0] + a[1] * a[1]) + (a[2] * a[2] + a[3] * a[3]) + (c[0] * c[0] + c[1] * c[1]) + (c[2] * c[2] + c[3] * c[3]); }
                ss += __shfl_xor(ss, 16); ss += __shfl_xor(ss, 32);
                if (fq == 0) SSQ1P[(size_t)row * 32 + u.pn * 4 + wc] = ss; }
        EPI_PAIR_END
    }
};
struct EpiOut {
    static constexpr bool PERM = true;
    const float* X1F; float* OUT; const bf16* PPROJ; const float* SSQ1P; const bf16* X1G;
    __device__ __forceinline__ void operator()(const f32x4 (&acc)[2][2][4][2], const Unit& u, int wr, int wc, int fr, int fq) const {
        const int cl = u.pn * 256 + wc * 32 + 8 * fq; const float* __restrict__ x1f = X1F; float* __restrict__ out = OUT; const bf16* __restrict__ pp = MK_PP_SPLIT ? (const bf16*)((const unsigned char*)PPROJ + pp_quarter_off(u.pm >> 3)) : PPROJ; const float* __restrict__ sq = SSQ1P;
        EPI_PAIR_BEGIN
            f32x4 xv[2][2][2]; v4u xg[2][2]; v4u pv[2][2]; f32x4 sv[2][2];
#pragma unroll
            for (int g = 0; g < 2; ++g) { const int row = EPI_ROW_OF(g);
#pragma unroll
                for (int j = 0; j < 2; ++j) sv[g][j] = *(const f32x4*)(sq + (size_t)row * 32 + 8 * fq + 4 * j);
#pragma unroll
                for (int bj = 0; bj < 2; ++bj) { const size_t off = (size_t)row * 2048 + cl + bj * 128; if (MK_X1_BF16) xg[g][bj] = *(const v4u*)(X1G + off); else { xv[g][bj][0] = *(const f32x4*)(x1f + off); xv[g][bj][1] = *(const f32x4*)(x1f + off + 4); } pv[g][bj] = (MK_NT_IN >= 2 ? __builtin_nontemporal_load((const v4u*)(pp + off)) : *((const v4u*)(pp + off))); } }
#pragma unroll
            for (int g = 0; g < 2; ++g) { float ss = 0.f;
#pragma unroll
                for (int j = 0; j < 2; ++j) ss += (sv[g][j][0] + sv[g][j][1]) + (sv[g][j][2] + sv[g][j][3]);
                ss += __shfl_xor(ss, 16); ss += __shfl_xor(ss, 32);
                const float r1 = 1.0f / sqrtf(ss * (1.f / DM) + EPS);
#pragma unroll
                for (int bj = 0; bj < 2; ++bj) { const size_t off = (size_t)EPI_ROW_OF(g) * 2048 + cl + bj * 128; float p[8]; unpack8(pv[g][bj], p);
                    f32x4 a, c; if (MK_X1_BF16) { float x8[8]; unpack8(xg[g][bj], x8); a = (f32x4){x8[0], x8[1], x8[2], x8[3]}; c = (f32x4){x8[4], x8[5], x8[6], x8[7]}; } else { a = xv[g][bj][0]; c = xv[g][bj][1]; }
                    const f32x4 ga = EPI_ACC(g, bj, 0), gc = EPI_ACC(g, bj, 1);
#pragma unroll
                    for (int j = 0; j < 4; ++j) { a[j] += sigmoidf_(r1 * ga[j]) * p[j]; c[j] += sigmoidf_(r1 * gc[j]) * p[4 + j]; }
                    *(f32x4*)(out + off) = a; *(f32x4*)(out + off + 4) = c; } }
        EPI_PAIR_END
    }
};

__device__ __forceinline__ void p2_rowpass(const Frame& F, const Args& A) {
    unsigned char* ws = A.ws;
    const float* ZS = (const float*)(ws + WS_ZS); const bf16* CONV4 = (const bf16*)(ws + WS_CONV4);
    bf16* QLAT = (bf16*)(ws + WS_QLAT); bf16* KVLAT = (bf16*)(ws + WS_KVLAT); float* RK = (float*)(ws + WS_RK); float* SSQKPE = (float*)(ws + WS_SSQKPE); bf16* CVG = (bf16*)((unsigned char*)A.out + OUT_ACAT);
    const float* COS = (const float*)(ws + WS_COS); const float* SIN = (const float*)(ws + WS_SIN);
    const int gw = F.vcu * NWAVES + F.wave, NGW = F.G * NWAVES, lane = lane_id_opaque();
    for (int t0 = 4 * gw; t0 < MTOK; t0 += 4 * NGW) {
        if (MK_LAT_FUSE >= 2) {} else
        if (MK_LAT_FUSE) {
          float kp[4], cs[4], sn[4]; const int fi = lane & 31; const float* KPE = (const float*)(ws + WS_KPE);
#pragma unroll
          for (int q = 0; q < 4; ++q) { kp[q] = KPE[(size_t)(t0 + q) * 64 + lane]; cs[q] = COS[(size_t)(t0 + q) * 32 + fi]; sn[q] = SIN[(size_t)(t0 + q) * 32 + fi]; }
          const float gk = A.k_norm_g[DNOPE + lane];
#pragma unroll
          for (int q = 0; q < 4; ++q) { const int t = t0 + q;
              const float ssq = wave_sum(kp[q] * kp[q]); const float v = kp[q] * gk; const float vo = __shfl_xor(v, 32);
              RK[(size_t)t * 64 + lane] = (lane < 32) ? (v * cs[q] - vo * sn[q]) : (v * cs[q] + vo * sn[q]);
              if (lane == 0) SSQKPE[t] = ssq; } }
        else
        { f32x4 qa[4], qb[4], ka[4]; float kp[4], cs[4], sn[4]; const int fi = lane & 31;
#pragma unroll
          for (int q = 0; q < 4; ++q) {
              if (MK_ZS_BF16) { const bf16* zb = (const bf16*)ZS + (size_t)(t0 + q) * 1024; const v2u a2 = *(const v2u*)(zb + 4 * lane), b2 = *(const v2u*)(zb + 256 + 4 * lane), c2 = *(const v2u*)(zb + 512 + 4 * lane);
                  qa[q] = (f32x4){bflo(a2.x), bfhi(a2.x), bflo(a2.y), bfhi(a2.y)}; qb[q] = (f32x4){bflo(b2.x), bfhi(b2.x), bflo(b2.y), bfhi(b2.y)}; ka[q] = (f32x4){bflo(c2.x), bfhi(c2.x), bflo(c2.y), bfhi(c2.y)};
                  kp[q] = bflo((unsigned)zb[768 + lane]); }
              else { const float* zr = ZS + (size_t)(t0 + q) * 1024; qa[q] = *(const f32x4*)(zr + 4 * lane); qb[q] = *(const f32x4*)(zr + 256 + 4 * lane); ka[q] = *(const f32x4*)(zr + 512 + 4 * lane);
              kp[q] = zr[768 + lane]; }
              cs[q] = COS[(size_t)(t0 + q) * 32 + fi]; sn[q] = SIN[(size_t)(t0 + q) * 32 + fi]; }
          const float gk = A.k_norm_g[DNOPE + lane];
#pragma unroll
          for (int q = 0; q < 4; ++q) { const int t = t0 + q; const f32x4 a = qa[q], b = qb[q], c = ka[q];
              float s = (a[0] * a[0] + a[1] * a[1]) + (a[2] * a[2] + a[3] * a[3]) + (b[0] * b[0] + b[1] * b[1]) + (b[2] * b[2] + b[3] * b[3]);
              const float rs = 1.0f / sqrtf(wave_sum(s) * (1.f / QR) + EPS);
              { unsigned char* q8 = (unsigned char*)QLAT + (size_t)t * QR;
                *(unsigned*)(q8 + 4 * lane) = pack4_fp8(a[0] * rs, a[1] * rs, a[2] * rs, a[3] * rs); *(unsigned*)(q8 + 256 + 4 * lane) = pack4_fp8(b[0] * rs, b[1] * rs, b[2] * rs, b[3] * rs); }
              float s2 = (c[0] * c[0] + c[1] * c[1]) + (c[2] * c[2] + c[3] * c[3]);
              const float rk = 1.0f / sqrtf(wave_sum(s2) * (1.f / KVR) + EPS);
              v2u w2; w2.x = pk2(c[0] * rk, c[1] * rk); w2.y = pk2(c[2] * rk, c[3] * rk);
              *(v2u*)(KVLAT + (size_t)t * KVR + 4 * lane) = w2;
              const float ssq = wave_sum(kp[q] * kp[q]); const float v = kp[q] * gk; const float vo = __shfl_xor(v, 32);
              RK[(size_t)t * 64 + lane] = (lane < 32) ? (v * cs[q] - vo * sn[q]) : (v * cs[q] + vo * sn[q]);
              if (lane == 0) SSQKPE[t] = ssq; } }
        if (!MK_CONV_FUSE)
        { const int sq0 = t0 & (SEQ - 1); const bool hasp = sq0 > 0, hasn = sq0 + 4 < SEQ;
          const bf16* r0 = CONV4 + (size_t)t0 * 4096;
#pragma unroll
          for (int ch = 0; ch < 2; ++ch) { const int c0 = ch * 512 + 8 * lane;
            v4u rc[6], rx[6], rb[4], rg[4];
#pragma unroll
            for (int q = 0; q < 6; ++q) { const bool ok = (q == 0) ? hasp : ((q == 5) ? hasn : true);
                if (ok) { rc[q] = *(const v4u*)(r0 + (ptrdiff_t)(q - 1) * 4096 + 1024 + c0); rx[q] = *(const v4u*)(r0 + (ptrdiff_t)(q - 1) * 4096 + 2048 + c0); } else { rc[q] = (v4u){0u, 0u, 0u, 0u}; rx[q] = (v4u){0u, 0u, 0u, 0u}; } }
#pragma unroll
            for (int q = 0; q < 4; ++q) { rb[q] = *(const v4u*)(r0 + (size_t)q * 4096 + c0); rg[q] = *(const v4u*)(r0 + (size_t)q * 4096 + 3072 + c0); }
            const f32x4 w0a = *(const f32x4*)(A.conv_w + c0), w0b = *(const f32x4*)(A.conv_w + c0 + 4), w1a = *(const f32x4*)(A.conv_w + 1024 + c0), w1b = *(const f32x4*)(A.conv_w + 1024 + c0 + 4),
                        w2a = *(const f32x4*)(A.conv_w + 2048 + c0), w2b = *(const f32x4*)(A.conv_w + 2048 + c0 + 4), bba = *(const f32x4*)(A.conv_b + c0), bbb = *(const f32x4*)(A.conv_b + c0 + 4);
            float u[6][8];
#pragma unroll
            for (int q = 0; q < 6; ++q) { float c8[8], x8[8]; unpack8(rc[q], c8); unpack8(rx[q], x8);
#pragma unroll
                for (int j = 0; j < 8; ++j) u[q][j] = c8[j] * x8[j]; }
#pragma unroll
            for (int q = 0; q < 4; ++q) { float cb[8], gc[8], o[8]; unpack8(rb[q], cb); unpack8(rg[q], gc);
#pragma unroll
                for (int j = 0; j < 8; ++j) { const float w0 = j < 4 ? w0a[j] : w0b[j - 4], w1 = j < 4 ? w1a[j] : w1b[j - 4], w2 = j < 4 ? w2a[j] : w2b[j - 4], bb = j < 4 ? bba[j] : bbb[j - 4];
                    const float cv = cb[j] * (u[q][j] * w0 + u[q + 1][j] * w1 + u[q + 2][j] * w2 + bb);
                    o[j] = cv * siluf_(gc[j]); }
                v4u w; w.x = pk2(o[0], o[1]); w.y = pk2(o[2], o[3]); w.z = pk2(o[4], o[5]); w.w = pk2(o[6], o[7]);
                *(v4u*)(CVG + (size_t)(t0 + q) * ACAT_LD + c0) = w; } } }
        if (MK_CONV_FUSE)
        { const int sq0 = t0 & (SEQ - 1); const bool hasp = sq0 > 0, hasn = sq0 + 4 < SEQ;
          const bf16* r0 = CONV4 + (size_t)t0 * 2048;
#pragma unroll
          for (int ch = 0; ch < 2; ++ch) { const int c0 = ch * 512 + 8 * lane;
            v4u ru[6], rbg[4];
#pragma unroll
            for (int q = 0; q < 6; ++q) { const bool ok = (q == 0) ? hasp : ((q == 5) ? hasn : true);
                if (ok) ru[q] = __builtin_nontemporal_load((const v4u*)(r0 + (ptrdiff_t)(q - 1) * 2048 + c0)); else ru[q] = (v4u){0u, 0u, 0u, 0u}; }
#pragma unroll
            for (int q = 0; q < 4; ++q) rbg[q] = (MK_NT_IN >= 2 ? __builtin_nontemporal_load((const v4u*)(r0 + (size_t)q * 2048 + 1024 + c0)) : *((const v4u*)(r0 + (size_t)q * 2048 + 1024 + c0)));
            const f32x4 w0a = *(const f32x4*)(A.conv_w + c0), w0b = *(const f32x4*)(A.conv_w + c0 + 4), w1a = *(const f32x4*)(A.conv_w + 1024 + c0), w1b = *(const f32x4*)(A.conv_w + 1024 + c0 + 4),
                        w2a = *(const f32x4*)(A.conv_w + 2048 + c0), w2b = *(const f32x4*)(A.conv_w + 2048 + c0 + 4), bba = *(const f32x4*)(A.conv_b + c0), bbb = *(const f32x4*)(A.conv_b + c0 + 4);
            float u[6][8];
#pragma unroll
            for (int q = 0; q < 6; ++q) unpack8(ru[q], u[q]);
#pragma unroll
            for (int q = 0; q < 4; ++q) { float bg[8], o[8]; unpack8(rbg[q], bg);
#pragma unroll
                for (int j = 0; j < 8; ++j) { const float w0 = j < 4 ? w0a[j] : w0b[j - 4], w1 = j < 4 ? w1a[j] : w1b[j - 4], w2 = j < 4 ? w2a[j] : w2b[j - 4], bb = j < 4 ? bba[j] : bbb[j - 4];
                    o[j] = bg[j] * (u[q][j] * w0 + u[q + 1][j] * w1 + u[q + 2][j] * w2 + bb); }
                v4u w; w.x = pk2(o[0], o[1]); w.y = pk2(o[2], o[3]); w.z = pk2(o[4], o[5]); w.w = pk2(o[6], o[7]);
                *(v4u*)(CVG + (size_t)(t0 + q) * ACAT_LD + c0) = w; } } }
    }
}

namespace att {
constexpr int KT_BYTES = 24576, VT_BYTES = 16384;
constexpr int NSLOT = 3, L_K = 0, L_V = NSLOT * KT_BYTES, L_WS = L_V + NSLOT * VT_BYTES, L_END = L_WS + NWAVES * 256;
static_assert(L_END <= RING_BYTES, "attention LDS");
constexpr float THR2 = 8.f * LOG2E;
#define SBAR() __builtin_amdgcn_sched_barrier(0)
__device__ __forceinline__ int crow(int r, int hi) { return (r & 3) + 8 * (r >> 2) + 4 * hi; }
__device__ __forceinline__ unsigned cvtpk(float lo, float hi) { unsigned r; asm volatile("v_cvt_pk_bf16_f32 %0, %1, %2" : "=v"(r) : "v"(lo), "v"(hi)); return r; }

__device__ __forceinline__ void partialSM(f32x16& p0, f32x16& p1, float& m_reg, float& alpha) {
    float pmax = p0[0];
#pragma unroll
    for (int r = 1; r < 16; ++r) pmax = fmaxf(pmax, p0[r]);
#pragma unroll
    for (int r = 0; r < 16; ++r) pmax = fmaxf(pmax, p1[r]);
    { auto rr = __builtin_amdgcn_permlane32_swap(__float_as_uint(pmax), __float_as_uint(pmax), false, false);
      pmax = fmaxf(__uint_as_float(rr[0]), __uint_as_float(rr[1])); }
    float mn;
    if (__builtin_expect(__all(pmax - m_reg <= THR2), 1)) { mn = m_reg; alpha = 1.f; }
    else { mn = fmaxf(m_reg, pmax); alpha = __builtin_amdgcn_exp2f(m_reg - mn); m_reg = mn; }
#pragma unroll
    for (int r = 0; r < 16; ++r) p0[r] = p0[r] - mn;
#pragma unroll
    for (int r = 0; r < 16; ++r) p1[r] = p1[r] - mn;
#pragma unroll
    for (int r = 0; r < 16; ++r) p0[r] = __builtin_amdgcn_exp2f(p0[r]);
}
__device__ __forceinline__ void finishSM(f32x16& p0, f32x16& p1, float alpha, float& l_reg, bf16x8& pa0, bf16x8& pa1, bf16x8& pa2, bf16x8& pa3) {
#pragma unroll
    for (int r = 0; r < 16; ++r) p1[r] = __builtin_amdgcn_exp2f(p1[r]);
    float ps = 0;
#pragma unroll
    for (int r = 0; r < 16; ++r) ps += p0[r];
#pragma unroll
    for (int r = 0; r < 16; ++r) ps += p1[r];
    { auto rr = __builtin_amdgcn_permlane32_swap(__float_as_uint(ps), __float_as_uint(ps), false, false);
      ps = __uint_as_float(rr[0]) + __uint_as_float(rr[1]); }
    l_reg = l_reg * alpha + ps;
#define PK4(P, BASE, OUT) do { unsigned a0 = cvtpk(P[BASE + 0], P[BASE + 1]), a1 = cvtpk(P[BASE + 2], P[BASE + 3]);   \
    unsigned b0 = cvtpk(P[BASE + 4], P[BASE + 5]), b1 = cvtpk(P[BASE + 6], P[BASE + 7]);                              \
    auto r0 = __builtin_amdgcn_permlane32_swap(a0, b0, false, false); auto r1 = __builtin_amdgcn_permlane32_swap(a1, b1, false, false); \
    v4u w = {r0[0], r1[0], r0[1], r1[1]}; OUT = __builtin_bit_cast(bf16x8, w); } while (0)
    PK4(p0, 0, pa0); PK4(p0, 8, pa1); PK4(p1, 0, pa2); PK4(p1, 8, pa3);
#undef PK4
}
__device__ __forceinline__ void qkt(f32x16& p0, f32x16& p1, const LAS unsigned char* Ks, const bf16x8 (&qr)[12], int r32, int hi) {
    p0 = f32x16{}; p1 = f32x16{};
#pragma unroll
    for (int d0 = 0; d0 < 12; ++d0) {
        const bf16x8 b0 = *(const LAS bf16x8*)(Ks + (2 * d0 + hi) * 1024 + r32 * 16);
        const bf16x8 b1 = *(const LAS bf16x8*)(Ks + (2 * d0 + hi) * 1024 + (32 + r32) * 16);
        p0 = __builtin_amdgcn_mfma_f32_32x32x16_bf16(b0, qr[d0], p0, 0, 0, 0);
        p1 = __builtin_amdgcn_mfma_f32_32x32x16_bf16(b1, qr[d0], p1, 0, 0, 0); }
}
__device__ __forceinline__ int v_rd_base(int lane) { return ((lane & 3) << 3) | (((lane >> 2) & 3) << 6) | (((lane >> 4) & 1) << 5) | (((lane >> 5) & 1) << 8); }
constexpr int v_rd_off(int d0, int ks, int half) { return d0 * 512 + ks * 4096 + half * 2048; }
template <int OFF> __device__ __forceinline__ s16x4 tr_read(int vb) {
    s16x4 r; asm volatile("ds_read_b64_tr_b16 %0, %1 offset:%2" : "=&v"(r) : "v"(vb), "i"(OFF) : "memory"); return r;
}
template <int D0> __device__ __forceinline__ void pv_one(f32x16& od, int vb, bf16x8 pa0, bf16x8 pa1, bf16x8 pa2, bf16x8 pa3) {
    const s16x4 l0 = tr_read<v_rd_off(D0, 0, 0)>(vb), h0 = tr_read<v_rd_off(D0, 0, 1)>(vb), l1 = tr_read<v_rd_off(D0, 1, 0)>(vb), h1 = tr_read<v_rd_off(D0, 1, 1)>(vb);
    const s16x4 l2 = tr_read<v_rd_off(D0, 2, 0)>(vb), h2 = tr_read<v_rd_off(D0, 2, 1)>(vb), l3 = tr_read<v_rd_off(D0, 3, 0)>(vb), h3 = tr_read<v_rd_off(D0, 3, 1)>(vb);
    asm volatile("s_waitcnt lgkmcnt(0)" ::: "memory"); SBAR();
#define PK(L, H) (bf16x8){L[0], L[1], L[2], L[3], H[0], H[1], H[2], H[3]}
    od = __builtin_amdgcn_mfma_f32_32x32x16_bf16(pa0, PK(l0, h0), od, 0, 0, 0);
    od = __builtin_amdgcn_mfma_f32_32x32x16_bf16(pa1, PK(l1, h1), od, 0, 0, 0);
    od = __builtin_amdgcn_mfma_f32_32x32x16_bf16(pa2, PK(l2, h2), od, 0, 0, 0);
    od = __builtin_amdgcn_mfma_f32_32x32x16_bf16(pa3, PK(l3, h3), od, 0, 0, 0);
#undef PK
}
__device__ __forceinline__ void pv_d0(f32x16 (&o)[4], int vb, bf16x8 pa0, bf16x8 pa1, bf16x8 pa2, bf16x8 pa3) {
    pv_one<0>(o[0], vb, pa0, pa1, pa2, pa3); pv_one<1>(o[1], vb, pa0, pa1, pa2, pa3); pv_one<2>(o[2], vb, pa0, pa1, pa2, pa3); pv_one<3>(o[3], vb, pa0, pa1, pa2, pa3);
}

template <int D0> __device__ __forceinline__ void pv_reads(int vb, s16x4 (&l)[4], s16x4 (&h)[4]) {
    l[0] = tr_read<v_rd_off(D0, 0, 0)>(vb); h[0] = tr_read<v_rd_off(D0, 0, 1)>(vb); l[1] = tr_read<v_rd_off(D0, 1, 0)>(vb); h[1] = tr_read<v_rd_off(D0, 1, 1)>(vb);
    l[2] = tr_read<v_rd_off(D0, 2, 0)>(vb); h[2] = tr_read<v_rd_off(D0, 2, 1)>(vb); l[3] = tr_read<v_rd_off(D0, 3, 0)>(vb); h[3] = tr_read<v_rd_off(D0, 3, 1)>(vb);
}
__device__ __forceinline__ void pv_mma(f32x16& od, const s16x4 (&l)[4], const s16x4 (&h)[4], bf16x8 pa0, bf16x8 pa1, bf16x8 pa2, bf16x8 pa3) {
    asm volatile("s_waitcnt lgkmcnt(0)" ::: "memory"); SBAR();
#define PK(L, H) (bf16x8){L[0], L[1], L[2], L[3], H[0], H[1], H[2], H[3]}
    od = __builtin_amdgcn_mfma_f32_32x32x16_bf16(pa0, PK(l[0], h[0]), od, 0, 0, 0);
    od = __builtin_amdgcn_mfma_f32_32x32x16_bf16(pa1, PK(l[1], h[1]), od, 0, 0, 0);
    od = __builtin_amdgcn_mfma_f32_32x32x16_bf16(pa2, PK(l[2], h[2]), od, 0, 0, 0);
    od = __builtin_amdgcn_mfma_f32_32x32x16_bf16(pa3, PK(l[3], h[3]), od, 0, 0, 0);
#undef PK
}
__device__ __forceinline__ void pv_sm(f32x16 (&o)[4], int vb, bf16x8 pa0, bf16x8 pa1, bf16x8 pa2, bf16x8 pa3, f32x16& p0, f32x16& p1, float& m_reg, float& alpha) {
    s16x4 l[4], h[4];
    pv_reads<0>(vb, l, h);
    float pmax = p0[0];
#pragma unroll
    for (int r = 1; r < 16; ++r) pmax = fmaxf(pmax, p0[r]);
    pv_mma(o[0], l, h, pa0, pa1, pa2, pa3);
    pv_reads<1>(vb, l, h);
#pragma unroll
    for (int r = 0; r < 16; ++r) pmax = fmaxf(pmax, p1[r]);
    { auto rr = __builtin_amdgcn_permlane32_swap(__float_as_uint(pmax), __float_as_uint(pmax), false, false);
      pmax = fmaxf(__uint_as_float(rr[0]), __uint_as_float(rr[1])); }
    pv_mma(o[1], l, h, pa0, pa1, pa2, pa3);
    pv_reads<2>(vb, l, h);
    float mn;
    if (__builtin_expect(__all(pmax - m_reg <= THR2), 1)) { mn = m_reg; alpha = 1.f; }
    else { mn = fmaxf(m_reg, pmax); alpha = __builtin_amdgcn_exp2f(m_reg - mn); m_reg = mn; }
#pragma unroll
    for (int r = 0; r < 16; ++r) p0[r] = p0[r] - mn;
    pv_mma(o[2], l, h, pa0, pa1, pa2, pa3);
    pv_reads<3>(vb, l, h);
#pragma unroll
    for (int r = 0; r < 16; ++r) p1[r] = p1[r] - mn;
    pv_mma(o[3], l, h, pa0, pa1, pa2, pa3);
#pragma unroll
    for (int r = 0; r < 16; ++r) p0[r] = __builtin_amdgcn_exp2f(p0[r]);
}

__device__ __forceinline__ void attn_unit(int b, int h, int qb, const bf16* Qraw, const bf16* KFp, const bf16* VTp, const bf16* GA, bf16* ATTG,
                                          const float* gq, const float* COS, const float* SIN, LAS unsigned char* lds, const int wid) {
    const int lane = lane_id_opaque(), tid = wid * 64 + lane, r32 = lane & 31, hi = lane >> 5;
    LAS float* wsf = (LAS float*)(lds + L_WS) + wid * 64; LAS float* li_l = wsf; LAS float* al_l = wsf + 32;
    const int tok0 = b * SEQ + qb * 256 + wid * 32;
    bf16x8 qr[12];
    {
        const int tok = tok0 + r32; const bf16* qp = Qraw + (size_t)tok * (NH * DQK) + h * DQK + hi * 8;
        v4u raw[12]; float ss = 0.f;
#pragma unroll
        for (int d0 = 0; d0 < 12; ++d0) { raw[d0] = *(const v4u*)(qp + d0 * 16); float f[8]; unpack8(raw[d0], f);
#pragma unroll
            for (int j = 0; j < 8; ++j) ss += f[j] * f[j]; }
        ss += __shfl_xor(ss, 32);
        const float CQ = 0.07216878364870322f * LOG2E;
        const float rs = (1.0f / sqrtf(ss * (1.f / DQK) + EPS));
#pragma unroll
        for (int d0 = 0; d0 < 8; ++d0) { float f[8]; unpack8(raw[d0], f); const f32x4 g0 = *(const f32x4*)(gq + d0 * 16 + hi * 8), g1 = *(const f32x4*)(gq + d0 * 16 + hi * 8 + 4);
            const float sc = rs * CQ;
            v4u w; w.x = cvtpk(f[0] * sc * g0[0], f[1] * sc * g0[1]); w.y = cvtpk(f[2] * sc * g0[2], f[3] * sc * g0[3]); w.z = cvtpk(f[4] * sc * g1[0], f[5] * sc * g1[1]); w.w = cvtpk(f[6] * sc * g1[2], f[7] * sc * g1[3]);
            qr[d0] = __builtin_bit_cast(bf16x8, w); }
#pragma unroll
        for (int e = 0; e < 2; ++e) {
            float f1[8], f2[8]; unpack8(raw[8 + e], f1); unpack8(raw[10 + e], f2);
            float o1[8], o2[8];
#pragma unroll
            for (int j = 0; j < 8; ++j) { const int i = 16 * e + 8 * hi + j; const float c = COS[(size_t)tok * 32 + i], s = SIN[(size_t)tok * 32 + i];
                const float v1 = f1[j] * rs * gq[DNOPE + i], v2 = f2[j] * rs * gq[DNOPE + 32 + i];
                o1[j] = (v1 * c - v2 * s) * CQ; o2[j] = (v2 * c + v1 * s) * CQ; }
            v4u w; w.x = cvtpk(o1[0], o1[1]); w.y = cvtpk(o1[2], o1[3]); w.z = cvtpk(o1[4], o1[5]); w.w = cvtpk(o1[6], o1[7]); qr[8 + e] = __builtin_bit_cast(bf16x8, w);
            v4u x; x.x = cvtpk(o2[0], o2[1]); x.y = cvtpk(o2[2], o2[3]); x.z = cvtpk(o2[4], o2[5]); x.w = cvtpk(o2[6], o2[7]); qr[10 + e] = __builtin_bit_cast(bf16x8, x);
        }
    }
    float m_reg = -1e30f, l_reg = 0.f; f32x16 o[4] = {};
    const unsigned char* Kg = (const unsigned char*)(KFp + (size_t)((b * NH + h) * 32) * 12288) + lane * 16;
    const unsigned char* Vg = (const unsigned char*)VTp + (size_t)((b * NH + h) * 32) * 16384 + lane * 16;
    LAS unsigned char* K_lds = lds + L_K; LAS unsigned char* V_lds = lds + L_V;
    const int vb0 = (int)(uintptr_t)V_lds + v_rd_base(lane);
#define DMA_K(t, slot) do { _Pragma("unroll") for (int i_ = 0; i_ < 3; ++i_) __builtin_amdgcn_global_load_lds((const unsigned*)(Kg + (size_t)(t) * KT_BYTES + (wid + 8 * i_) * 1024), \
        (LAS unsigned*)(K_lds + (slot) * KT_BYTES + (wid + 8 * i_) * 1024), 16, 0, 0); } while (0)
#define DMA_V(t, slot) do { _Pragma("unroll") for (int i_ = 0; i_ < 2; ++i_) __builtin_amdgcn_global_load_lds((const unsigned*)(Vg + (size_t)(t) * VT_BYTES + (wid + 8 * i_) * 1024), \
        (LAS unsigned*)(V_lds + (slot) * VT_BYTES + (wid + 8 * i_) * 1024), 16, 0, 0); } while (0)
#define WAIT_BAR(N) asm volatile("s_waitcnt vmcnt(" #N ")\n\ts_barrier" ::: "memory")
#define RESC(a) do { if (__any((a) < 1.f)) { if (hi == 0) al_l[r32] = (a); asm volatile("s_waitcnt lgkmcnt(0)" ::: "memory"); \
    _Pragma("unroll") for (int d = 0; d < 4; ++d) _Pragma("unroll") for (int r = 0; r < 16; ++r) o[d][r] *= al_l[crow(r, hi)]; } } while (0)
    f32x16 pA0, pA1, pB0, pB1; float alA, alB; bf16x8 pa0, pa1, pa2, pa3; constexpr int NT = SEQ / 64;
    DMA_K(0, 0); DMA_V(0, 0); DMA_K(1, 1);
    WAIT_BAR(0);
    DMA_K(2, 2); DMA_V(1, 1);
    qkt(pA0, pA1, K_lds, qr, r32, hi); partialSM(pA0, pA1, m_reg, alA);
    WAIT_BAR(5);
    int sk = 1, sv = 0;
#define NEXT3(x) ((x) == 2 ? 0 : (x) + 1)
#define PREV3(x) ((x) == 0 ? 2 : (x) - 1)
    for (int j = 1; j + 1 < NT; j += 2) {
        DMA_K(j + 2, PREV3(sk)); DMA_V(j + 1, NEXT3(sk));
        SBAR(); qkt(pB0, pB1, K_lds + sk * KT_BYTES, qr, r32, hi);
        finishSM(pA0, pA1, alA, l_reg, pa0, pa1, pa2, pa3); SBAR();
        pv_sm(o, vb0 + sv * VT_BYTES, pa0, pa1, pa2, pa3, pB0, pB1, m_reg, alB);
        RESC(alB);
        WAIT_BAR(5);
        sk = NEXT3(sk); sv = NEXT3(sv);
        const bool more = (j + 3 < NT);
        if (more) DMA_K(j + 3, PREV3(sk));
        DMA_V(j + 2, NEXT3(sk));
        SBAR(); qkt(pA0, pA1, K_lds + sk * KT_BYTES, qr, r32, hi);
        finishSM(pB0, pB1, alB, l_reg, pa0, pa1, pa2, pa3); SBAR();
        pv_sm(o, vb0 + sv * VT_BYTES, pa0, pa1, pa2, pa3, pA0, pA1, m_reg, alA);
        RESC(alA);
        if (more) WAIT_BAR(5); else WAIT_BAR(2);
        sk = NEXT3(sk); sv = NEXT3(sv);
    }
    SBAR(); qkt(pB0, pB1, K_lds + sk * KT_BYTES, qr, r32, hi);
    finishSM(pA0, pA1, alA, l_reg, pa0, pa1, pa2, pa3); SBAR();
    pv_sm(o, vb0 + sv * VT_BYTES, pa0, pa1, pa2, pa3, pB0, pB1, m_reg, alB);
    RESC(alB);
    WAIT_BAR(0);
    sv = NEXT3(sv);
    finishSM(pB0, pB1, alB, l_reg, pa0, pa1, pa2, pa3); SBAR();
    pv_d0(o, vb0 + sv * VT_BYTES, pa0, pa1, pa2, pa3);
    if (hi == 0) li_l[r32] = l_reg; asm volatile("s_waitcnt lgkmcnt(0)" ::: "memory");
    { unsigned short gv[16][4];
#pragma unroll
      for (int r = 0; r < 16; ++r) { const size_t ro = (size_t)(tok0 + crow(r, hi)) * 2048 + h * DV + r32;
#pragma unroll
          for (int d0 = 0; d0 < 4; ++d0) gv[r][d0] = GA[ro + d0 * 32]; }
#pragma unroll
      for (int r = 0; r < 16; ++r) { const int orow = crow(r, hi); const float rl = __builtin_amdgcn_rcpf(li_l[orow]); const size_t wo = (size_t)(tok0 + orow) * ACAT_LD + CW + h * DV + r32;
#pragma unroll
          for (int d0 = 0; d0 < 4; ++d0) { const float g = bflo((unsigned)gv[r][d0]); ATTG[wo + d0 * 32] = (bf16)f2bf(o[d0][r] * rl * siluf_(g)); } } }
    __syncthreads();
#undef DMA_K
#undef DMA_V
#undef WAIT_BAR
#undef NEXT3
#undef PREV3
#undef RESC
}

typedef int i32x8 __attribute__((ext_vector_type(8)));
constexpr int K8_BYTES = 12288, K8_SLOT = 16384;
constexpr int L8_K = 0, L8_V = NSLOT * K8_SLOT, L8_WS = L8_V + NSLOT * VT_BYTES, L8_END = L8_WS + NWAVES * 256;
constexpr float CQ8 = 0.07216878364870322f * LOG2E;
__device__ __forceinline__ void qkt8(f32x16& p0, f32x16& p1, const LAS unsigned char* Ks, const i32x8 (&qf)[3], int r32, int hi) {
    p0 = f32x16{}; p1 = f32x16{};
#pragma unroll
    for (int s = 0; s < 3; ++s) { const LAS unsigned char* c0 = Ks + ((s * 2 + hi) * 2) * 1024 + r32 * 16;
        const v4u a0l = *(const LAS v4u*)(c0), a0h = *(const LAS v4u*)(c0 + 1024), a1l = *(const LAS v4u*)(c0 + 512), a1h = *(const LAS v4u*)(c0 + 1024 + 512);
        const i32x8 a0 = {(int)a0l.x, (int)a0l.y, (int)a0l.z, (int)a0l.w, (int)a0h.x, (int)a0h.y, (int)a0h.z, (int)a0h.w};
        const i32x8 a1 = {(int)a1l.x, (int)a1l.y, (int)a1l.z, (int)a1l.w, (int)a1h.x, (int)a1h.y, (int)a1h.z, (int)a1h.w};
        p0 = __builtin_amdgcn_mfma_scale_f32_32x32x64_f8f6f4(a0, qf[s], p0, 0, 0, 0, 0x7F7F7F7F, 0, 0x7F7F7F7F);
        p1 = __builtin_amdgcn_mfma_scale_f32_32x32x64_f8f6f4(a1, qf[s], p1, 0, 0, 0, 0x7F7F7F7F, 0, 0x7F7F7F7F); }
}
__device__ __forceinline__ void partialSM8(f32x16& p0, f32x16& p1, float& m_reg, float& alpha) {
    float pmax = p0[0];
#pragma unroll
    for (int r = 1; r < 16; ++r) pmax = fmaxf(pmax, p0[r]);
#pragma unroll
    for (int r = 0; r < 16; ++r) pmax = fmaxf(pmax, p1[r]);
    { auto rr = __builtin_amdgcn_permlane32_swap(__float_as_uint(pmax), __float_as_uint(pmax), false, false);
      pmax = fmaxf(__uint_as_float(rr[0]), __uint_as_float(rr[1])); }
    float mn;
    if (__builtin_expect(__all((pmax - m_reg) * CQ8 <= THR2), 1)) { mn = m_reg; alpha = 1.f; }
    else { mn = fmaxf(m_reg, pmax); alpha = __builtin_amdgcn_exp2f((m_reg - mn) * CQ8); m_reg = mn; }
    const float mnC = -mn * CQ8;
#pragma unroll
    for (int r = 0; r < 16; ++r) p0[r] = fmaf(p0[r], CQ8, mnC);
#pragma unroll
    for (int r = 0; r < 16; ++r) p1[r] = fmaf(p1[r], CQ8, mnC);
#pragma unroll
    for (int r = 0; r < 16; ++r) p0[r] = __builtin_amdgcn_exp2f(p0[r]);
}
__device__ __forceinline__ void pv_sm8(f32x16 (&o)[4], int vb, bf16x8 pa0, bf16x8 pa1, bf16x8 pa2, bf16x8 pa3, f32x16& p0, f32x16& p1, float& m_reg, float& alpha) {
    s16x4 l[4], h[4];
    pv_reads<0>(vb, l, h);
    float pmax = p0[0];
#pragma unroll
    for (int r = 1; r < 16; ++r) pmax = fmaxf(pmax, p0[r]);
    pv_mma(o[0], l, h, pa0, pa1, pa2, pa3);
    pv_reads<1>(vb, l, h);
#pragma unroll
    for (int r = 0; r < 16; ++r) pmax = fmaxf(pmax, p1[r]);
    { auto rr = __builtin_amdgcn_permlane32_swap(__float_as_uint(pmax), __float_as_uint(pmax), false, false);
      pmax = fmaxf(__uint_as_float(rr[0]), __uint_as_float(rr[1])); }
    pv_mma(o[1], l, h, pa0, pa1, pa2, pa3);
    pv_reads<2>(vb, l, h);
    float mn;
    if (__builtin_expect(__all((pmax - m_reg) * CQ8 <= THR2), 1)) { mn = m_reg; alpha = 1.f; }
    else { mn = fmaxf(m_reg, pmax); alpha = __builtin_amdgcn_exp2f((m_reg - mn) * CQ8); m_reg = mn; }
    const float mnC = -mn * CQ8;
#pragma unroll
    for (int r = 0; r < 16; ++r) p0[r] = fmaf(p0[r], CQ8, mnC);
    pv_mma(o[2], l, h, pa0, pa1, pa2, pa3);
    pv_reads<3>(vb, l, h);
#pragma unroll
    for (int r = 0; r < 16; ++r) p1[r] = fmaf(p1[r], CQ8, mnC);
    pv_mma(o[3], l, h, pa0, pa1, pa2, pa3);
#pragma unroll
    for (int r = 0; r < 16; ++r) p0[r] = __builtin_amdgcn_exp2f(p0[r]);
}
template <bool CHECK>
__device__ __forceinline__ void attn_unit8(int b, int h, int qb, const bf16* Qraw, const unsigned char* KF8, const bf16* VTp, const bf16* GA, bf16* ATTG,
                                           const float* gq, const float* COS, const float* SIN, LAS unsigned char* lds, const int wid, float* chk) {
    const int lane = lane_id_opaque(), r32 = lane & 31, hi = lane >> 5;
    LAS float* wsf = (LAS float*)(lds + L8_WS) + wid * 64; LAS float* li_l = wsf; LAS float* al_l = wsf + 32;
    const int tok0 = b * SEQ + qb * 256 + wid * 32;
    i32x8 qf[3];
    {
        const int tok = tok0 + r32; const bf16* qp = Qraw + (size_t)tok * (NH * DQK) + h * DQK;
        v4u raw[12]; float ss = 0.f;
#pragma unroll
        for (int c = 0; c < 4; ++c) { raw[c] = *(const v4u*)(qp + 32 * hi + 8 * c); raw[4 + c] = *(const v4u*)(qp + 64 + 32 * hi + 8 * c); }
#pragma unroll
        for (int c = 0; c < 2; ++c) { raw[8 + c] = *(const v4u*)(qp + 128 + 16 * hi + 8 * c); raw[10 + c] = *(const v4u*)(qp + 160 + 16 * hi + 8 * c); }
#pragma unroll
        for (int c = 0; c < 12; ++c) { float f[8]; unpack8(raw[c], f);
#pragma unroll
            for (int j = 0; j < 8; ++j) ss += f[j] * f[j]; }
        ss += __shfl_xor(ss, 32);
        const float rs = (1.0f / sqrtf(ss * (1.f / DQK) + EPS));
#pragma unroll
        for (int s2 = 0; s2 < 2; ++s2)
#pragma unroll
            for (int c = 0; c < 4; ++c) { float f[8]; unpack8(raw[4 * s2 + c], f); const float* gp = gq + 64 * s2 + 32 * hi + 8 * c; const f32x4 g0 = *(const f32x4*)gp, g1 = *(const f32x4*)(gp + 4);
                qf[s2][2 * c] = (int)pack4_fp8(f[0] * rs * g0[0], f[1] * rs * g0[1], f[2] * rs * g0[2], f[3] * rs * g0[3]);
                qf[s2][2 * c + 1] = (int)pack4_fp8(f[4] * rs * g1[0], f[5] * rs * g1[1], f[6] * rs * g1[2], f[7] * rs * g1[3]); }
#pragma unroll
        for (int c = 0; c < 2; ++c) { float f1[8], f2[8], o1[8], o2[8]; unpack8(raw[8 + c], f1); unpack8(raw[10 + c], f2);
#pragma unroll
            for (int j = 0; j < 8; ++j) { const int i = 16 * hi + 8 * c + j; const float cs = COS[(size_t)tok * 32 + i], sn = SIN[(size_t)tok * 32 + i];
                const float v1 = f1[j] * rs * gq[DNOPE + i], v2 = f2[j] * rs * gq[DNOPE + 32 + i];
                o1[j] = v1 * cs - v2 * sn; o2[j] = v2 * cs + v1 * sn; }
            qf[2][2 * c] = (int)pack4_fp8(o1[0], o1[1], o1[2], o1[3]); qf[2][2 * c + 1] = (int)pack4_fp8(o1[4], o1[5], o1[6], o1[7]);
            qf[2][4 + 2 * c] = (int)pack4_fp8(o2[0], o2[1], o2[2], o2[3]); qf[2][4 + 2 * c + 1] = (int)pack4_fp8(o2[4], o2[5], o2[6], o2[7]); }
    }
    float m_reg = -1e30f, l_reg = 0.f; f32x16 o[4] = {};
    const unsigned char* Kg = KF8 + (size_t)(((b & 1) * NH + h) * 32) * K8_BYTES + lane * 16;
    const unsigned char* Vg = (const unsigned char*)VTp + (size_t)((b * NH + h) * 32) * 16384 + lane * 16;
    LAS unsigned char* K_lds = lds + L8_K; LAS unsigned char* V_lds = lds + L8_V;
    const int vb0 = (int)(uintptr_t)V_lds + v_rd_base(lane);
    const int kp1 = (wid + 8 < 12) ? wid + 8 : wid + 4;
#define DMA_K(t, slot) do { __builtin_amdgcn_global_load_lds((const unsigned*)(Kg + (size_t)(t) * K8_BYTES + wid * 1024), (LAS unsigned*)(K_lds + (slot) * K8_SLOT + wid * 1024), 16, 0, 0); \
        __builtin_amdgcn_global_load_lds((const unsigned*)(Kg + (size_t)(t) * K8_BYTES + kp1 * 1024), (LAS unsigned*)(K_lds + (slot) * K8_SLOT + (wid + 8) * 1024), 16, 0, 0); } while (0)
#define DMA_V(t, slot) do { _Pragma("unroll") for (int i_ = 0; i_ < 2; ++i_) __builtin_amdgcn_global_load_lds((const unsigned*)(Vg + (size_t)(t) * VT_BYTES + (wid + 8 * i_) * 1024), \
        (LAS unsigned*)(V_lds + (slot) * VT_BYTES + (wid + 8 * i_) * 1024), 16, 0, 0); } while (0)
#define WAIT_BAR(N) asm volatile("s_waitcnt vmcnt(" #N ")\n\ts_barrier" ::: "memory")
#define RESC(a) do { if (__any((a) < 1.f)) { if (hi == 0) al_l[r32] = (a); asm volatile("s_waitcnt lgkmcnt(0)" ::: "memory"); \
    _Pragma("unroll") for (int d = 0; d < 4; ++d) _Pragma("unroll") for (int r = 0; r < 16; ++r) o[d][r] *= al_l[crow(r, hi)]; } } while (0)
    f32x16 pA0, pA1, pB0, pB1; float alA, alB; bf16x8 pa0, pa1, pa2, pa3; constexpr int NT = SEQ / 64;
    DMA_K(0, 0); DMA_V(0, 0); DMA_K(1, 1);
    WAIT_BAR(0);
    DMA_K(2, 2); DMA_V(1, 1);
    qkt8(pA0, pA1, K_lds, qf, r32, hi); partialSM8(pA0, pA1, m_reg, alA);
    WAIT_BAR(4);
    int sk = 1, sv = 0;
#define NEXT3(x) ((x) == 2 ? 0 : (x) + 1)
#define PREV3(x) ((x) == 0 ? 2 : (x) - 1)
    for (int j = 1; j + 1 < NT; j += 2) {
        DMA_K(j + 2, PREV3(sk)); DMA_V(j + 1, NEXT3(sk));
        SBAR(); qkt8(pB0, pB1, K_lds + sk * K8_SLOT, qf, r32, hi);
        finishSM(pA0, pA1, alA, l_reg, pa0, pa1, pa2, pa3); SBAR();
        pv_sm8(o, vb0 + sv * VT_BYTES, pa0, pa1, pa2, pa3, pB0, pB1, m_reg, alB);
        RESC(alB);
        WAIT_BAR(4);
        sk = NEXT3(sk); sv = NEXT3(sv);
        const bool more = (j + 3 < NT);
        if (more) DMA_K(j + 3, PREV3(sk));
        DMA_V(j + 2, NEXT3(sk));
        SBAR(); qkt8(pA0, pA1, K_lds + sk * K8_SLOT, qf, r32, hi);
        finishSM(pB0, pB1, alB, l_reg, pa0, pa1, pa2, pa3); SBAR();
        pv_sm8(o, vb0 + sv * VT_BYTES, pa0, pa1, pa2, pa3, pA0, pA1, m_reg, alA);
        RESC(alA);
        if (more) WAIT_BAR(4); else WAIT_BAR(2);
        sk = NEXT3(sk); sv = NEXT3(sv);
    }
    SBAR(); qkt8(pB0, pB1, K_lds + sk * K8_SLOT, qf, r32, hi);
    finishSM(pA0, pA1, alA, l_reg, pa0, pa1, pa2, pa3); SBAR();
    pv_sm8(o, vb0 + sv * VT_BYTES, pa0, pa1, pa2, pa3, pB0, pB1, m_reg, alB);
    RESC(alB);
    WAIT_BAR(0);
    sv = NEXT3(sv);
    finishSM(pB0, pB1, alB, l_reg, pa0, pa1, pa2, pa3); SBAR();
    pv_d0(o, vb0 + sv * VT_BYTES, pa0, pa1, pa2, pa3);
    if (hi == 0) li_l[r32] = l_reg; asm volatile("s_waitcnt lgkmcnt(0)" ::: "memory");
    { unsigned short gv[16][4];
#pragma unroll
      for (int r = 0; r < 16; ++r) { const size_t ro = (size_t)(tok0 + crow(r, hi)) * 2048 + h * DV + r32;
#pragma unroll
          for (int d0 = 0; d0 < 4; ++d0) gv[r][d0] = GA[ro + d0 * 32]; }
      float dsum = 0.f, rsum = 0.f;
#pragma unroll
      for (int r = 0; r < 16; ++r) { const int orow = crow(r, hi); const float rl = __builtin_amdgcn_rcpf(li_l[orow]); const size_t wo = (size_t)(tok0 + orow) * ACAT_LD + CW + h * DV + r32;
#pragma unroll
          for (int d0 = 0; d0 < 4; ++d0) { const float g = bflo((unsigned)gv[r][d0]); const unsigned vb = f2bf(o[d0][r] * rl * siluf_(g));
              if (CHECK) { const float ref = bflo((unsigned)ATTG[wo + d0 * 32]), val = bflo(vb); dsum += (val - ref) * (val - ref); rsum += ref * ref; }
              else ATTG[wo + d0 * 32] = (bf16)vb; } }
      if (CHECK) { dsum = wave_sum(dsum); rsum = wave_sum(rsum); if (lane == 0) { atomicAdd(chk, dsum); atomicAdd(chk + 1, rsum); } } }
    WAIT_BAR(0);
#undef DMA_K
#undef DMA_V
#undef WAIT_BAR
#undef NEXT3
#undef PREV3
#undef RESC
}

constexpr int V8_BYTES = 8192;
constexpr int L88_K = 0, L88_V = NSLOT * K8_SLOT, L88_WS = L88_V + NSLOT * V8_BYTES, L88_END = L88_WS + NWAVES * 256;
constexpr float THR2_8 = 5.5f * LOG2E;
__device__ __forceinline__ void finishSM88(f32x16& p0, f32x16& p1, float alpha, float& l_reg, i32x8& pa) {
#pragma unroll
    for (int r = 0; r < 16; ++r) p1[r] = __builtin_amdgcn_exp2f(p1[r]);
    float ps = 0;
#pragma unroll
    for (int r = 0; r < 16; ++r) ps += p0[r];
#pragma unroll
    for (int r = 0; r < 16; ++r) ps += p1[r];
    { auto rr = __builtin_amdgcn_permlane32_swap(__float_as_uint(ps), __float_as_uint(ps), false, false);
      ps = __uint_as_float(rr[0]) + __uint_as_float(rr[1]); }
    l_reg = l_reg * alpha + ps;
#pragma unroll
    for (int w = 0; w < 4; ++w) { pa[w] = (int)pack4_fp8(p0[4 * w], p0[4 * w + 1], p0[4 * w + 2], p0[4 * w + 3]); pa[4 + w] = (int)pack4_fp8(p1[4 * w], p1[4 * w + 1], p1[4 * w + 2], p1[4 * w + 3]); }
}
__device__ __forceinline__ i32x8 v8_frag(const LAS unsigned char* Vs, int b4, int r32, int hi) {
    const LAS unsigned char* c0 = Vs + ((b4 * 2 + hi) * 2) * 512 + r32 * 16; const v4u lo = *(const LAS v4u*)c0, hh = *(const LAS v4u*)(c0 + 512);
    return (i32x8){(int)lo.x, (int)lo.y, (int)lo.z, (int)lo.w, (int)hh.x, (int)hh.y, (int)hh.z, (int)hh.w};
}
#define MFMA8(A, B, C) __builtin_amdgcn_mfma_scale_f32_32x32x64_f8f6f4(A, B, C, 0, 0, 0, 0x7F7F7F7F, 0, 0x7F7F7F7F)
__device__ __forceinline__ void pv88(f32x16 (&o)[4], const LAS unsigned char* Vs, const i32x8& pa, int r32, int hi) {
#pragma unroll
    for (int b4 = 0; b4 < 4; ++b4) o[b4] = MFMA8(pa, v8_frag(Vs, b4, r32, hi), o[b4]);
}
__device__ __forceinline__ void pv_sm88(f32x16 (&o)[4], const LAS unsigned char* Vs, const i32x8& pa, int r32, int hi, f32x16& p0, f32x16& p1, float& m_reg, float& alpha) {
    i32x8 vf = v8_frag(Vs, 0, r32, hi);
    float pmax = p0[0];
#pragma unroll
    for (int r = 1; r < 16; ++r) pmax = fmaxf(pmax, p0[r]);
    o[0] = MFMA8(pa, vf, o[0]);
    vf = v8_frag(Vs, 1, r32, hi);
#pragma unroll
    for (int r = 0; r < 16; ++r) pmax = fmaxf(pmax, p1[r]);
    { auto rr = __builtin_amdgcn_permlane32_swap(__float_as_uint(pmax), __float_as_uint(pmax), false, false);
      pmax = fmaxf(__uint_as_float(rr[0]), __uint_as_float(rr[1])); }
    o[1] = MFMA8(pa, vf, o[1]);
    vf = v8_frag(Vs, 2, r32, hi);
    float mn;
    if (__builtin_expect(__all((pmax - m_reg) * CQ8 <= THR2_8), 1)) { mn = m_reg; alpha = 1.f; }
    else { mn = fmaxf(m_reg, pmax); alpha = __builtin_amdgcn_exp2f((m_reg - mn) * CQ8); m_reg = mn; }
    const float mnC = -mn * CQ8;
#pragma unroll
    for (int r = 0; r < 16; ++r) p0[r] = fmaf(p0[r], CQ8, mnC);
    o[2] = MFMA8(pa, vf, o[2]);
    vf = v8_frag(Vs, 3, r32, hi);
#pragma unroll
    for (int r = 0; r < 16; ++r) p1[r] = fmaf(p1[r], CQ8, mnC);
    o[3] = MFMA8(pa, vf, o[3]);
#pragma unroll
    for (int r = 0; r < 16; ++r) p0[r] = __builtin_amdgcn_exp2f(p0[r]);
}
__device__ __forceinline__ void partialSM88(f32x16& p0, f32x16& p1, float& m_reg, float& alpha) {
    float pmax = p0[0];
#pragma unroll
    for (int r = 1; r < 16; ++r) pmax = fmaxf(pmax, p0[r]);
#pragma unroll
    for (int r = 0; r < 16; ++r) pmax = fmaxf(pmax, p1[r]);
    { auto rr = __builtin_amdgcn_permlane32_swap(__float_as_uint(pmax), __float_as_uint(pmax), false, false);
      pmax = fmaxf(__uint_as_float(rr[0]), __uint_as_float(rr[1])); }
    float mn;
    if (__builtin_expect(__all((pmax - m_reg) * CQ8 <= THR2_8), 1)) { mn = m_reg; alpha = 1.f; }
    else { mn = fmaxf(m_reg, pmax); alpha = __builtin_amdgcn_exp2f((m_reg - mn) * CQ8); m_reg = mn; }
    const float mnC = -mn * CQ8;
#pragma unroll
    for (int r = 0; r < 16; ++r) p0[r] = fmaf(p0[r], CQ8, mnC);
#pragma unroll
    for (int r = 0; r < 16; ++r) p1[r] = fmaf(p1[r], CQ8, mnC);
#pragma unroll
    for (int r = 0; r < 16; ++r) p0[r] = __builtin_amdgcn_exp2f(p0[r]);
}
__device__ __forceinline__ void attn_unit88(int b, int h, int qb, const bf16* Qraw, const unsigned char* KF8, const unsigned char* V8, const bf16* GA, bf16* ATTG,
                                            const float* gq, const float* COS, const float* SIN, LAS unsigned char* lds, const int wid) {
    const int lane = lane_id_opaque(), r32 = lane & 31, hi = lane >> 5;
    LAS float* wsf = (LAS float*)(lds + L88_WS) + wid * 64; LAS float* li_l = wsf; LAS float* al_l = wsf + 32;
    const int tok0 = b * SEQ + qb * 256 + wid * 32;
    i32x8 qf[3];
    {
        const int tok = tok0 + r32; const bf16* qp = Qraw + (size_t)tok * (NH * DQK) + h * DQK;
        v4u raw[12]; float ss = 0.f;
#pragma unroll
        for (int c = 0; c < 4; ++c) { raw[c] = *(const v4u*)(qp + 32 * hi + 8 * c); raw[4 + c] = *(const v4u*)(qp + 64 + 32 * hi + 8 * c); }
#pragma unroll
        for (int c = 0; c < 2; ++c) { raw[8 + c] = *(const v4u*)(qp + 128 + 16 * hi + 8 * c); raw[10 + c] = *(const v4u*)(qp + 160 + 16 * hi + 8 * c); }
#pragma unroll
        for (int c = 0; c < 12; ++c) { float f[8]; unpack8(raw[c], f);
#pragma unroll
            for (int j = 0; j < 8; ++j) ss += f[j] * f[j]; }
        ss += __shfl_xor(ss, 32);
        const float rs = (1.0f / sqrtf(ss * (1.f / DQK) + EPS));
#pragma unroll
        for (int s2 = 0; s2 < 2; ++s2)
#pragma unroll
            for (int c = 0; c < 4; ++c) { float f[8]; unpack8(raw[4 * s2 + c], f); const float* gp = gq + 64 * s2 + 32 * hi + 8 * c; const f32x4 g0 = *(const f32x4*)gp, g1 = *(const f32x4*)(gp + 4);
                qf[s2][2 * c] = (int)pack4_fp8(f[0] * rs * g0[0], f[1] * rs * g0[1], f[2] * rs * g0[2], f[3] * rs * g0[3]);
                qf[s2][2 * c + 1] = (int)pack4_fp8(f[4] * rs * g1[0], f[5] * rs * g1[1], f[6] * rs * g1[2], f[7] * rs * g1[3]); }
#pragma unroll
        for (int c = 0; c < 2; ++c) { float f1[8], f2[8], o1[8], o2[8]; unpack8(raw[8 + c], f1); unpack8(raw[10 + c], f2);
#pragma unroll
            for (int j = 0; j < 8; ++j) { const int i = 16 * hi + 8 * c + j; const float cs = COS[(size_t)tok * 32 + i], sn = SIN[(size_t)tok * 32 + i];
                const float v1 = f1[j] * rs * gq[DNOPE + i], v2 = f2[j] * rs * gq[DNOPE + 32 + i];
                o1[j] = v1 * cs - v2 * sn; o2[j] = v2 * cs + v1 * sn; }
            qf[2][2 * c] = (int)pack4_fp8(o1[0], o1[1], o1[2], o1[3]); qf[2][2 * c + 1] = (int)pack4_fp8(o1[4], o1[5], o1[6], o1[7]);
            qf[2][4 + 2 * c] = (int)pack4_fp8(o2[0], o2[1], o2[2], o2[3]); qf[2][4 + 2 * c + 1] = (int)pack4_fp8(o2[4], o2[5], o2[6], o2[7]); }
    }
    float m_reg = -1e30f, l_reg = 0.f; f32x16 o[4] = {};
    const unsigned char* Kg = KF8 + (size_t)(((b & 1) * NH + h) * 32) * K8_BYTES + lane * 16;
    const unsigned char* Vg = V8 + (size_t)((b * NH + h) * 32) * V8_BYTES + lane * 16;
    LAS unsigned char* K_lds = lds + L88_K; LAS unsigned char* V_lds = lds + L88_V;
    const int kp1 = (wid + 8 < 12) ? wid + 8 : wid + 4;
#define DMA_K(t, slot) do { __builtin_amdgcn_global_load_lds((const unsigned*)(Kg + (size_t)(t) * K8_BYTES + wid * 1024), (LAS unsigned*)(K_lds + (slot) * K8_SLOT + wid * 1024), 16, 0, 0); \
        __builtin_amdgcn_global_load_lds((const unsigned*)(Kg + (size_t)(t) * K8_BYTES + kp1 * 1024), (LAS unsigned*)(K_lds + (slot) * K8_SLOT + (wid + 8) * 1024), 16, 0, 0); } while (0)
#define DMA_V(t, slot) __builtin_amdgcn_global_load_lds((const unsigned*)(Vg + (size_t)(t) * V8_BYTES + wid * 1024), (LAS unsigned*)(V_lds + (slot) * V8_BYTES + wid * 1024), 16, 0, 0)
#define WAIT_BAR(N) asm volatile("s_waitcnt vmcnt(" #N ")\n\ts_barrier" ::: "memory")
#define RESC(a) do { if (__any((a) < 1.f)) { if (hi == 0) al_l[r32] = (a); asm volatile("s_waitcnt lgkmcnt(0)" ::: "memory"); \
    _Pragma("unroll") for (int d = 0; d < 4; ++d) _Pragma("unroll") for (int r = 0; r < 16; ++r) o[d][r] *= al_l[crow(r, hi)]; } } while (0)
    f32x16 pA0, pA1, pB0, pB1; float alA, alB; i32x8 pa; constexpr int NT = SEQ / 64;
    DMA_K(0, 0); DMA_V(0, 0); DMA_K(1, 1);
    WAIT_BAR(0);
    DMA_K(2, 2); DMA_V(1, 1);
    qkt8(pA0, pA1, K_lds, qf, r32, hi); partialSM88(pA0, pA1, m_reg, alA);
    WAIT_BAR(3);
    int sk = 1, sv = 0;
#define NEXT3(x) ((x) == 2 ? 0 : (x) + 1)
#define PREV3(x) ((x) == 0 ? 2 : (x) - 1)
    for (int j = 1; j + 1 < NT; j += 2) {
        DMA_K(j + 2, PREV3(sk)); DMA_V(j + 1, NEXT3(sk));
        SBAR(); qkt8(pB0, pB1, K_lds + sk * K8_SLOT, qf, r32, hi);
        finishSM88(pA0, pA1, alA, l_reg, pa); SBAR();
        pv_sm88(o, V_lds + sv * V8_BYTES, pa, r32, hi, pB0, pB1, m_reg, alB);
        RESC(alB);
        WAIT_BAR(3);
        sk = NEXT3(sk); sv = NEXT3(sv);
        const bool more = (j + 3 < NT);
        if (more) DMA_K(j + 3, PREV3(sk));
        DMA_V(j + 2, NEXT3(sk));
        SBAR(); qkt8(pA0, pA1, K_lds + sk * K8_SLOT, qf, r32, hi);
        finishSM88(pB0, pB1, alB, l_reg, pa); SBAR();
        pv_sm88(o, V_lds + sv * V8_BYTES, pa, r32, hi, pA0, pA1, m_reg, alA);
        RESC(alA);
        if (more) WAIT_BAR(3); else WAIT_BAR(1);
        sk = NEXT3(sk); sv = NEXT3(sv);
    }
    SBAR(); qkt8(pB0, pB1, K_lds + sk * K8_SLOT, qf, r32, hi);
    finishSM88(pA0, pA1, alA, l_reg, pa); SBAR();
    pv_sm88(o, V_lds + sv * V8_BYTES, pa, r32, hi, pB0, pB1, m_reg, alB);
    RESC(alB);
    WAIT_BAR(0);
    sv = NEXT3(sv);
    finishSM88(pB0, pB1, alB, l_reg, pa); SBAR();
    pv88(o, V_lds + sv * V8_BYTES, pa, r32, hi);
    if (hi == 0) li_l[r32] = l_reg; asm volatile("s_waitcnt lgkmcnt(0)" ::: "memory");
    { unsigned short gv[16][4];
#pragma unroll
      for (int r = 0; r < 16; ++r) { const size_t ro = (size_t)(tok0 + crow(r, hi)) * 2048 + h * DV + r32;
#pragma unroll
          for (int d0 = 0; d0 < 4; ++d0) gv[r][d0] = GA[ro + d0 * 32]; }
#pragma unroll
      for (int r = 0; r < 16; ++r) { const int orow = crow(r, hi); const float rl = __builtin_amdgcn_rcpf(li_l[orow]); const size_t wo = (size_t)(tok0 + orow) * ACAT_LD + CW + h * DV + r32;
#pragma unroll
          for (int d0 = 0; d0 < 4; ++d0) { const float g = bflo((unsigned)gv[r][d0]); ATTG[wo + d0 * 32] = (bf16)f2bf(o[d0][r] * rl * siluf_(g)); } } }
    WAIT_BAR(0);
#undef DMA_K
#undef DMA_V
#undef WAIT_BAR
#undef NEXT3
#undef PREV3
#undef RESC
}

__device__ __forceinline__ void qkt8n(f32x16& p0, f32x16& p1, const LAS unsigned char* Ks, const i32x8 (&qf)[3], const f32x16& negm, int r32, int hi) {
#pragma unroll
    for (int s = 0; s < 3; ++s) { const LAS unsigned char* c0 = Ks + ((s * 2 + hi) * 2) * 1024 + r32 * 16;
        const v4u a0l = *(const LAS v4u*)(c0), a0h = *(const LAS v4u*)(c0 + 1024), a1l = *(const LAS v4u*)(c0 + 512), a1h = *(const LAS v4u*)(c0 + 1024 + 512);
        const i32x8 a0 = {(int)a0l.x, (int)a0l.y, (int)a0l.z, (int)a0l.w, (int)a0h.x, (int)a0h.y, (int)a0h.z, (int)a0h.w};
        const i32x8 a1 = {(int)a1l.x, (int)a1l.y, (int)a1l.z, (int)a1l.w, (int)a1h.x, (int)a1h.y, (int)a1h.z, (int)a1h.w};
        if (s == 0) { p0 = MFMA8(a0, qf[s], negm); p1 = MFMA8(a1, qf[s], negm); } else { p0 = MFMA8(a0, qf[s], p0); p1 = MFMA8(a1, qf[s], p1); } }
}
__device__ __forceinline__ float rowmax32(const f32x16& p0, const f32x16& p1) {
    float pmax = p0[0];
#pragma unroll
    for (int r = 1; r < 16; ++r) pmax = fmaxf(pmax, p0[r]);
#pragma unroll
    for (int r = 0; r < 16; ++r) pmax = fmaxf(pmax, p1[r]);
    auto rr = __builtin_amdgcn_permlane32_swap(__float_as_uint(pmax), __float_as_uint(pmax), false, false);
    return fmaxf(__uint_as_float(rr[0]), __uint_as_float(rr[1]));
}
template <bool FIRST> __device__ __forceinline__ float decide9(f32x16& p0, f32x16& p1, float pmax, float& mhat, f32x16& negm) {
    float al = 1.f;
    if (FIRST || __builtin_expect(__any(pmax > THR2_8), 0)) { const float dl = FIRST ? pmax : fmaxf(pmax, 0.f); mhat += dl;
#pragma unroll
        for (int r = 0; r < 16; ++r) { p0[r] -= dl; p1[r] -= dl; }
#pragma unroll
        for (int r = 0; r < 16; ++r) negm[r] = -mhat;
        asm volatile("" : "+v"(negm));
        al = __builtin_amdgcn_exp2f(-dl); }
    return al;
}
__device__ __forceinline__ void finishSM9(f32x16& p0, f32x16& p1, i32x8& pa) {
#pragma unroll
    for (int r = 0; r < 16; ++r) p1[r] = __builtin_amdgcn_exp2f(p1[r]);
#pragma unroll
    for (int w = 0; w < 4; ++w) { pa[w] = (int)pack4_fp8(p0[4 * w], p0[4 * w + 1], p0[4 * w + 2], p0[4 * w + 3]); pa[4 + w] = (int)pack4_fp8(p1[4 * w], p1[4 * w + 1], p1[4 * w + 2], p1[4 * w + 3]); }
}
__device__ __forceinline__ float pv_sm9(f32x16 (&o)[4], f32x16& lacc, const LAS unsigned char* Vs, const i32x8& pa, int r32, int hi, f32x16& p0, f32x16& p1, float& mhat, f32x16& negm) {
    const i32x8 ones = {0x38383838, 0x38383838, 0x38383838, 0x38383838, 0x38383838, 0x38383838, 0x38383838, 0x38383838};
    i32x8 vf = v8_frag(Vs, 0, r32, hi);
    float pmax = p0[0];
#pragma unroll
    for (int r = 1; r < 16; ++r) pmax = fmaxf(pmax, p0[r]);
    o[0] = MFMA8(pa, vf, o[0]);
    vf = v8_frag(Vs, 1, r32, hi);
#pragma unroll
    for (int r = 0; r < 16; ++r) pmax = fmaxf(pmax, p1[r]);
    { auto rr = __builtin_amdgcn_permlane32_swap(__float_as_uint(pmax), __float_as_uint(pmax), false, false);
      pmax = fmaxf(__uint_as_float(rr[0]), __uint_as_float(rr[1])); }
    o[1] = MFMA8(pa, vf, o[1]);
    vf = v8_frag(Vs, 2, r32, hi);
    lacc = MFMA8(pa, ones, lacc);
    const float al = decide9<false>(p0, p1, pmax, mhat, negm);
    o[2] = MFMA8(pa, vf, o[2]);
    vf = v8_frag(Vs, 3, r32, hi);
    o[3] = MFMA8(pa, vf, o[3]);
#pragma unroll
    for (int r = 0; r < 16; ++r) p0[r] = __builtin_amdgcn_exp2f(p0[r]);
    return al;
}
__device__ __forceinline__ void attn_unit89(int b, int h, int qb, const bf16* Qraw, const unsigned char* KF8, const unsigned char* V8, const bf16* GA, bf16* ATTG,
                                            const float* gq, const float* COS, const float* SIN, LAS unsigned char* lds, const int wid) {
    const int lane = lane_id_opaque(), r32 = lane & 31, hi = lane >> 5;
    LAS float* al_l = (LAS float*)(lds + L88_WS) + wid * 64;
    const int tok0 = b * SEQ + qb * 256 + wid * 32;
    i32x8 qf[3];
    {
        const int tok = tok0 + r32; const bf16* qp = Qraw + (size_t)tok * (NH * DQK) + h * DQK;
        v4u raw[12]; float ss = 0.f;
#pragma unroll
        for (int c = 0; c < 4; ++c) { raw[c] = *(const v4u*)(qp + 32 * hi + 8 * c); raw[4 + c] = *(const v4u*)(qp + 64 + 32 * hi + 8 * c); }
#pragma unroll
        for (int c = 0; c < 2; ++c) { raw[8 + c] = *(const v4u*)(qp + 128 + 16 * hi + 8 * c); raw[10 + c] = *(const v4u*)(qp + 160 + 16 * hi + 8 * c); }
#pragma unroll
        for (int c = 0; c < 12; ++c) { float f[8]; unpack8(raw[c], f);
#pragma unroll
            for (int j = 0; j < 8; ++j) ss += f[j] * f[j]; }
        ss += __shfl_xor(ss, 32);
        const float rs = (1.0f / sqrtf(ss * (1.f / DQK) + EPS)) * CQ8;
#pragma unroll
        for (int s2 = 0; s2 < 2; ++s2)
#pragma unroll
            for (int c = 0; c < 4; ++c) { float f[8]; unpack8(raw[4 * s2 + c], f); const float* gp = gq + 64 * s2 + 32 * hi + 8 * c; const f32x4 g0 = *(const f32x4*)gp, g1 = *(const f32x4*)(gp + 4);
                qf[s2][2 * c] = (int)pack4_fp8(f[0] * rs * g0[0], f[1] * rs * g0[1], f[2] * rs * g0[2], f[3] * rs * g0[3]);
                qf[s2][2 * c + 1] = (int)pack4_fp8(f[4] * rs * g1[0], f[5] * rs * g1[1], f[6] * rs * g1[2], f[7] * rs * g1[3]); }
#pragma unroll
        for (int c = 0; c < 2; ++c) { float f1[8], f2[8], o1[8], o2[8]; unpack8(raw[8 + c], f1); unpack8(raw[10 + c], f2);
#pragma unroll
            for (int j = 0; j < 8; ++j) { const int i = 16 * hi + 8 * c + j; const float cs = COS[(size_t)tok * 32 + i], sn = SIN[(size_t)tok * 32 + i];
                const float v1 = f1[j] * rs * gq[DNOPE + i], v2 = f2[j] * rs * gq[DNOPE + 32 + i];
                o1[j] = v1 * cs - v2 * sn; o2[j] = v2 * cs + v1 * sn; }
            qf[2][2 * c] = (int)pack4_fp8(o1[0], o1[1], o1[2], o1[3]); qf[2][2 * c + 1] = (int)pack4_fp8(o1[4], o1[5], o1[6], o1[7]);
            qf[2][4 + 2 * c] = (int)pack4_fp8(o2[0], o2[1], o2[2], o2[3]); qf[2][4 + 2 * c + 1] = (int)pack4_fp8(o2[4], o2[5], o2[6], o2[7]); }
    }
    float mhat = 0.f; f32x16 o[4] = {}; f32x16 lacc = {}; f32x16 negm = {}; asm volatile("" : "+v"(negm));
    const unsigned char* Kg = KF8 + (size_t)(((b & 1) * NH + h) * 32) * K8_BYTES + lane * 16;
    const unsigned char* Vg = V8 + (size_t)((b * NH + h) * 32) * V8_BYTES + lane * 16;
    LAS unsigned char* K_lds = lds + L88_K; LAS unsigned char* V_lds = lds + L88_V;
    const int kp1 = (wid + 8 < 12) ? wid + 8 : wid + 4;
#define DMA_K(t, slot) do { __builtin_amdgcn_global_load_lds((const unsigned*)(Kg + (size_t)(t) * K8_BYTES + wid * 1024), (LAS unsigned*)(K_lds + (slot) * K8_SLOT + wid * 1024), 16, 0, 0); \
        __builtin_amdgcn_global_load_lds((const unsigned*)(Kg + (size_t)(t) * K8_BYTES + kp1 * 1024), (LAS unsigned*)(K_lds + (slot) * K8_SLOT + (wid + 8) * 1024), 16, 0, 0); } while (0)
#define DMA_V(t, slot) __builtin_amdgcn_global_load_lds((const unsigned*)(Vg + (size_t)(t) * V8_BYTES + wid * 1024), (LAS unsigned*)(V_lds + (slot) * V8_BYTES + wid * 1024), 16, 0, 0)
#define WAIT_BAR(N) asm volatile("s_waitcnt vmcnt(" #N ")\n\ts_barrier" ::: "memory")
#define RESC(a) do { if (__any((a) < 1.f)) { if (hi == 0) al_l[r32] = (a); asm volatile("s_waitcnt lgkmcnt(0)" ::: "memory"); \
    _Pragma("unroll") for (int r = 0; r < 16; ++r) { const float f_ = al_l[crow(r, hi)]; lacc[r] *= f_; _Pragma("unroll") for (int d = 0; d < 4; ++d) o[d][r] *= f_; } } } while (0)
    f32x16 pA0, pA1, pB0, pB1; float alA, alB; i32x8 pa; constexpr int NT = SEQ / 64;
    DMA_K(0, 0); DMA_V(0, 0); DMA_K(1, 1);
    WAIT_BAR(0);
    DMA_K(2, 2); DMA_V(1, 1);
    qkt8n(pA0, pA1, K_lds, qf, negm, r32, hi);
    { const float pm = rowmax32(pA0, pA1); alA = decide9<true>(pA0, pA1, pm, mhat, negm);
#pragma unroll
      for (int r = 0; r < 16; ++r) pA0[r] = __builtin_amdgcn_exp2f(pA0[r]); }
    WAIT_BAR(3);
    int sk = 1, sv = 0;
#define NEXT3(x) ((x) == 2 ? 0 : (x) + 1)
#define PREV3(x) ((x) == 0 ? 2 : (x) - 1)
    for (int j = 1; j + 1 < NT; j += 2) {
        DMA_K(j + 2, PREV3(sk)); DMA_V(j + 1, NEXT3(sk));
        SBAR(); qkt8n(pB0, pB1, K_lds + sk * K8_SLOT, qf, negm, r32, hi);
        finishSM9(pA0, pA1, pa); SBAR();
        alB = pv_sm9(o, lacc, V_lds + sv * V8_BYTES, pa, r32, hi, pB0, pB1, mhat, negm);
        RESC(alB);
        WAIT_BAR(3);
        sk = NEXT3(sk); sv = NEXT3(sv);
        const bool more = (j + 3 < NT);
        if (more) DMA_K(j + 3, PREV3(sk));
        DMA_V(j + 2, NEXT3(sk));
        SBAR(); qkt8n(pA0, pA1, K_lds + sk * K8_SLOT, qf, negm, r32, hi);
        finishSM9(pB0, pB1, pa); SBAR();
        alA = pv_sm9(o, lacc, V_lds + sv * V8_BYTES, pa, r32, hi, pA0, pA1, mhat, negm);
        RESC(alA);
        if (more) WAIT_BAR(3); else WAIT_BAR(1);
        sk = NEXT3(sk); sv = NEXT3(sv);
    }
    SBAR(); qkt8n(pB0, pB1, K_lds + sk * K8_SLOT, qf, negm, r32, hi);
    finishSM9(pA0, pA1, pa); SBAR();
    alB = pv_sm9(o, lacc, V_lds + sv * V8_BYTES, pa, r32, hi, pB0, pB1, mhat, negm);
    RESC(alB);
    WAIT_BAR(0);
    sv = NEXT3(sv);
    finishSM9(pB0, pB1, pa); SBAR();
    { const i32x8 ones = {0x38383838, 0x38383838, 0x38383838, 0x38383838, 0x38383838, 0x38383838, 0x38383838, 0x38383838};
      pv88(o, V_lds + sv * V8_BYTES, pa, r32, hi); lacc = MFMA8(pa, ones, lacc); }
    { unsigned short gv[16][4];
#pragma unroll
      for (int r = 0; r < 16; ++r) { const size_t ro = (size_t)(tok0 + crow(r, hi)) * 2048 + h * DV + r32;
#pragma unroll
          for (int d0 = 0; d0 < 4; ++d0) gv[r][d0] = GA[ro + d0 * 32]; }
#pragma unroll
      for (int r = 0; r < 16; ++r) { const int orow = crow(r, hi); const float rl = __builtin_amdgcn_rcpf(lacc[r]);
          if (MK_BA_FP8) { unsigned char* wp = (unsigned char*)ATTG + (size_t)(tok0 + orow) * (2 * ACAT_LD) + 2 * CW + h * DV + r32;
              const float sc = rl * ATT8_SCALE;
              const unsigned w4 = pack4_fp8(o[0][r] * sc * siluf_(bflo((unsigned)gv[r][0])), o[1][r] * sc * siluf_(bflo((unsigned)gv[r][1])), o[2][r] * sc * siluf_(bflo((unsigned)gv[r][2])), o[3][r] * sc * siluf_(bflo((unsigned)gv[r][3])));
              wp[0] = (unsigned char)w4; wp[32] = (unsigned char)(w4 >> 8); wp[64] = (unsigned char)(w4 >> 16); wp[96] = (unsigned char)(w4 >> 24); }
          else { const size_t wo = (size_t)(tok0 + orow) * ACAT_LD + CW + h * DV + r32;
#pragma unroll
              for (int d0 = 0; d0 < 4; ++d0) { const float g = bflo((unsigned)gv[r][d0]); ATTG[wo + d0 * 32] = (bf16)f2bf(o[d0][r] * rl * siluf_(g)); } } } }
    WAIT_BAR(0);
#undef DMA_K
#undef DMA_V
#undef WAIT_BAR
#undef NEXT3
#undef PREV3
#undef RESC
}
constexpr int NSLOT4 = 4, L90_K = 0, L90_V = NSLOT4 * K8_SLOT, L90_WS = L90_V + NSLOT4 * V8_BYTES, L90_END = L90_WS + NWAVES * 256;
static_assert(L90_END <= RING_BYTES, "attention (4-slot rings) LDS");
__device__ __forceinline__ void attn_unit90(int b, int h, int qb, const bf16* Qraw, const unsigned char* KF8, const unsigned char* V8, const bf16* GA, bf16* ATTG,
                                            const float* gq, const float* COS, const float* SIN, LAS unsigned char* lds, const int wid) {
    const int lane = lane_id_opaque(), r32 = lane & 31, hi = lane >> 5;
    LAS float* al_l = (LAS float*)(lds + L90_WS) + wid * 64;
    const int tok0 = b * SEQ + qb * 256 + wid * 32;
    const unsigned char* Kg = KF8 + (size_t)(((b & 1) * NH + h) * 32) * K8_BYTES + lane * 16;
    const unsigned char* Vg = V8 + (size_t)((b * NH + h) * 32) * V8_BYTES + lane * 16;
    LAS unsigned char* K_lds = lds + L90_K; LAS unsigned char* V_lds = lds + L90_V;
    const int kp1 = (wid + 8 < 12) ? wid + 8 : wid + 4;
#define DMA_K(t, slot) do { __builtin_amdgcn_global_load_lds((const unsigned*)(Kg + (size_t)(t) * K8_BYTES + wid * 1024), (LAS unsigned*)(K_lds + (slot) * K8_SLOT + wid * 1024), 16, 0, 0); \
        __builtin_amdgcn_global_load_lds((const unsigned*)(Kg + (size_t)(t) * K8_BYTES + kp1 * 1024), (LAS unsigned*)(K_lds + (slot) * K8_SLOT + (wid + 8) * 1024), 16, 0, 0); } while (0)
#define DMA_V(t, slot) __builtin_amdgcn_global_load_lds((const unsigned*)(Vg + (size_t)(t) * V8_BYTES + wid * 1024), (LAS unsigned*)(V_lds + (slot) * V8_BYTES + wid * 1024), 16, 0, 0)
#define WAIT_BAR(N) asm volatile("s_waitcnt vmcnt(" #N ")\n\ts_barrier" ::: "memory")
    DMA_K(0, 0); DMA_V(0, 0); DMA_K(1, 1); DMA_K(2, 2); DMA_V(1, 1);
    i32x8 qf[3];
    {
        const int tok = tok0 + r32;
#if MK_Q_FP8
#define UNPACK_Q(w, f) unpack8_f8(w, f)
        const unsigned char* qp = (const unsigned char*)Qraw + (size_t)tok * (NH * DQK) + h * DQK;
        v2u raw[12]; float ss = 0.f;
#pragma unroll
        for (int c = 0; c < 4; ++c) { raw[c] = (MK_NT_IN >= 2 ? __builtin_nontemporal_load((const v2u*)(qp + 32 * hi + 8 * c)) : *((const v2u*)(qp + 32 * hi + 8 * c))); raw[4 + c] = (MK_NT_IN >= 2 ? __builtin_nontemporal_load((const v2u*)(qp + 64 + 32 * hi + 8 * c)) : *((const v2u*)(qp + 64 + 32 * hi + 8 * c))); }
#pragma unroll
        for (int c = 0; c < 2; ++c) { raw[8 + c] = (MK_NT_IN >= 2 ? __builtin_nontemporal_load((const v2u*)(qp + 128 + 16 * hi + 8 * c)) : *((const v2u*)(qp + 128 + 16 * hi + 8 * c))); raw[10 + c] = (MK_NT_IN >= 2 ? __builtin_nontemporal_load((const v2u*)(qp + 160 + 16 * hi + 8 * c)) : *((const v2u*)(qp + 160 + 16 * hi + 8 * c))); }
#else
#define UNPACK_Q(w, f) unpack8(w, f)
        const bf16* qp = Qraw + (size_t)tok * (NH * DQK) + h * DQK;
        v4u raw[12]; float ss = 0.f;
#pragma unroll
        for (int c = 0; c < 4; ++c) { raw[c] = *(const v4u*)(qp + 32 * hi + 8 * c); raw[4 + c] = *(const v4u*)(qp + 64 + 32 * hi + 8 * c); }
#pragma unroll
        for (int c = 0; c < 2; ++c) { raw[8 + c] = *(const v4u*)(qp + 128 + 16 * hi + 8 * c); raw[10 + c] = *(const v4u*)(qp + 160 + 16 * hi + 8 * c); }
#endif
#pragma unroll
        for (int c = 0; c < 12; ++c) { float f[8]; UNPACK_Q(raw[c], f);
#pragma unroll
            for (int j = 0; j < 8; ++j) ss += f[j] * f[j]; }
        ss += __shfl_xor(ss, 32);
        const float rs = MK_Q_FP8 ? (1.0f / sqrtf(ss * (1.f / (64.f * DQK)) + EPS)) * (CQ8 * 0.125f) : (1.0f / sqrtf(ss * (1.f / DQK) + EPS)) * CQ8;
#pragma unroll
        for (int s2 = 0; s2 < 2; ++s2)
#pragma unroll
            for (int c = 0; c < 4; ++c) { float f[8]; UNPACK_Q(raw[4 * s2 + c], f); const float* gp = gq + 64 * s2 + 32 * hi + 8 * c; const f32x4 g0 = *(const f32x4*)gp, g1 = *(const f32x4*)(gp + 4);
                qf[s2][2 * c] = (int)pack4_fp8(f[0] * rs * g0[0], f[1] * rs * g0[1], f[2] * rs * g0[2], f[3] * rs * g0[3]);
                qf[s2][2 * c + 1] = (int)pack4_fp8(f[4] * rs * g1[0], f[5] * rs * g1[1], f[6] * rs * g1[2], f[7] * rs * g1[3]); }
#pragma unroll
        for (int c = 0; c < 2; ++c) { float f1[8], f2[8], o1[8], o2[8]; UNPACK_Q(raw[8 + c], f1); UNPACK_Q(raw[10 + c], f2);
#pragma unroll
            for (int j = 0; j < 8; ++j) { const int i = 16 * hi + 8 * c + j; const float cs = COS[(size_t)tok * 32 + i], sn = SIN[(size_t)tok * 32 + i];
                const float v1 = f1[j] * rs * gq[DNOPE + i], v2 = f2[j] * rs * gq[DNOPE + 32 + i];
                o1[j] = v1 * cs - v2 * sn; o2[j] = v2 * cs + v1 * sn; }
            qf[2][2 * c] = (int)pack4_fp8(o1[0], o1[1], o1[2], o1[3]); qf[2][2 * c + 1] = (int)pack4_fp8(o1[4], o1[5], o1[6], o1[7]);
            qf[2][4 + 2 * c] = (int)pack4_fp8(o2[0], o2[1], o2[2], o2[3]); qf[2][4 + 2 * c + 1] = (int)pack4_fp8(o2[4], o2[5], o2[6], o2[7]); }
    }
    float mhat = 0.f; f32x16 o[4] = {}; f32x16 lacc = {}; f32x16 negm = {}; asm volatile("" : "+v"(negm));
#define RESC(a) do { if (__any((a) < 1.f)) { if (hi == 0) al_l[r32] = (a); asm volatile("s_waitcnt lgkmcnt(0)" ::: "memory"); \
    _Pragma("unroll") for (int r = 0; r < 16; ++r) { const float f_ = al_l[crow(r, hi)]; lacc[r] *= f_; _Pragma("unroll") for (int d = 0; d < 4; ++d) o[d][r] *= f_; } } } while (0)
    f32x16 pA0, pA1, pB0, pB1; float alA, alB; i32x8 pa; constexpr int NT = SEQ / 64;
    WAIT_BAR(0);
    qkt8n(pA0, pA1, K_lds, qf, negm, r32, hi);
    { const float pm = rowmax32(pA0, pA1); alA = decide9<true>(pA0, pA1, pm, mhat, negm);
#pragma unroll
      for (int r = 0; r < 16; ++r) pA0[r] = __builtin_amdgcn_exp2f(pA0[r]); }
    WAIT_BAR(0);
    for (int j = 1; j + 1 < NT; j += 2) {
        DMA_K(j + 2, (j + 2) & 3); if (j + 3 < NT) DMA_K(j + 3, (j + 3) & 3);
        DMA_V(j + 1, (j + 1) & 3); DMA_V(j + 2, (j + 2) & 3);
        SBAR(); qkt8n(pB0, pB1, K_lds + (j & 3) * K8_SLOT, qf, negm, r32, hi);
        finishSM9(pA0, pA1, pa); SBAR();
        alB = pv_sm9(o, lacc, V_lds + ((j - 1) & 3) * V8_BYTES, pa, r32, hi, pB0, pB1, mhat, negm);
        RESC(alB);
        SBAR(); qkt8n(pA0, pA1, K_lds + ((j + 1) & 3) * K8_SLOT, qf, negm, r32, hi);
        finishSM9(pB0, pB1, pa); SBAR();
        alA = pv_sm9(o, lacc, V_lds + (j & 3) * V8_BYTES, pa, r32, hi, pA0, pA1, mhat, negm);
        RESC(alA);
        WAIT_BAR(0);
    }
    SBAR(); qkt8n(pB0, pB1, K_lds + ((NT - 1) & 3) * K8_SLOT, qf, negm, r32, hi);
    finishSM9(pA0, pA1, pa); SBAR();
    alB = pv_sm9(o, lacc, V_lds + ((NT - 2) & 3) * V8_BYTES, pa, r32, hi, pB0, pB1, mhat, negm);
    RESC(alB);
    finishSM9(pB0, pB1, pa); SBAR();
    { const i32x8 ones = {0x38383838, 0x38383838, 0x38383838, 0x38383838, 0x38383838, 0x38383838, 0x38383838, 0x38383838};
      pv88(o, V_lds + ((NT - 1) & 3) * V8_BYTES, pa, r32, hi); lacc = MFMA8(pa, ones, lacc); }
    if (MK_ATT_PERM && MK_GA_FP8 && MK_BA_FP8) { unsigned gw[16]; const unsigned char* G8 = (const unsigned char*)GA;
#pragma unroll
      for (int r = 0; r < 16; ++r) gw[r] = (MK_NT_IN >= 2 ? __builtin_nontemporal_load((const unsigned*)(G8 + (size_t)(tok0 + crow(r, hi)) * 2048 + h * DV + 4 * r32)) : *((const unsigned*)(G8 + (size_t)(tok0 + crow(r, hi)) * 2048 + h * DV + 4 * r32)));
#pragma unroll
      for (int r = 0; r < 16; ++r) { const int orow = crow(r, hi); const float rl = __builtin_amdgcn_rcpf(lacc[r]);
          unsigned char* wp = (unsigned char*)ATTG + (size_t)(tok0 + orow) * (2 * ACAT_LD) + 2 * CW + h * DV + 4 * r32;
          const float sc = rl * (ATT8_SCALE / 16.f);
          *(unsigned*)wp = pack4_fp8(o[0][r] * sc * __builtin_amdgcn_cvt_f32_fp8((int)gw[r], 0), o[1][r] * sc * __builtin_amdgcn_cvt_f32_fp8((int)gw[r], 1),
                                     o[2][r] * sc * __builtin_amdgcn_cvt_f32_fp8((int)gw[r], 2), o[3][r] * sc * __builtin_amdgcn_cvt_f32_fp8((int)gw[r], 3)); } }
    else
    if (MK_GA_FP8 && MK_BA_FP8) { unsigned char gb[16][4]; const unsigned char* G8 = (const unsigned char*)GA;
#pragma unroll
      for (int r = 0; r < 16; ++r) { const size_t ro = (size_t)(tok0 + crow(r, hi)) * 2048 + h * DV + r32;
#pragma unroll
          for (int d0 = 0; d0 < 4; ++d0) gb[r][d0] = G8[ro + d0 * 32]; }
#pragma unroll
      for (int r = 0; r < 16; ++r) { const int orow = crow(r, hi); const float rl = __builtin_amdgcn_rcpf(lacc[r]);
          unsigned char* wp = (unsigned char*)ATTG + (size_t)(tok0 + orow) * (2 * ACAT_LD) + 2 * CW + h * DV + r32;
          const float sc = rl * (ATT8_SCALE / 16.f);
          const unsigned w4 = pack4_fp8(o[0][r] * sc * __builtin_amdgcn_cvt_f32_fp8((int)gb[r][0], 0), o[1][r] * sc * __builtin_amdgcn_cvt_f32_fp8((int)gb[r][1], 0),
                                        o[2][r] * sc * __builtin_amdgcn_cvt_f32_fp8((int)gb[r][2], 0), o[3][r] * sc * __builtin_amdgcn_cvt_f32_fp8((int)gb[r][3], 0));
          wp[0] = (unsigned char)w4; wp[32] = (unsigned char)(w4 >> 8); wp[64] = (unsigned char)(w4 >> 16); wp[96] = (unsigned char)(w4 >> 24); } }
    else
    { unsigned short gv[16][4];
#pragma unroll
      for (int r = 0; r < 16; ++r) { const size_t ro = (size_t)(tok0 + crow(r, hi)) * 2048 + h * DV + r32;
#pragma unroll
          for (int d0 = 0; d0 < 4; ++d0) gv[r][d0] = GA[ro + d0 * 32]; }
#pragma unroll
      for (int r = 0; r < 16; ++r) { const int orow = crow(r, hi); const float rl = __builtin_amdgcn_rcpf(lacc[r]);
          if (MK_BA_FP8) { unsigned char* wp = (unsigned char*)ATTG + (size_t)(tok0 + orow) * (2 * ACAT_LD) + 2 * CW + h * DV + r32;
              const float sc = rl * ATT8_SCALE;
              const unsigned w4 = pack4_fp8(o[0][r] * sc * siluf_(bflo((unsigned)gv[r][0])), o[1][r] * sc * siluf_(bflo((unsigned)gv[r][1])), o[2][r] * sc * siluf_(bflo((unsigned)gv[r][2])), o[3][r] * sc * siluf_(bflo((unsigned)gv[r][3])));
              wp[0] = (unsigned char)w4; wp[32] = (unsigned char)(w4 >> 8); wp[64] = (unsigned char)(w4 >> 16); wp[96] = (unsigned char)(w4 >> 24); }
          else { const size_t wo = (size_t)(tok0 + orow) * ACAT_LD + CW + h * DV + r32;
#pragma unroll
              for (int d0 = 0; d0 < 4; ++d0) { const float g = bflo((unsigned)gv[r][d0]); ATTG[wo + d0 * 32] = (bf16)f2bf(o[d0][r] * rl * siluf_(g)); } } } }
    WAIT_BAR(0);
#undef DMA_K
#undef DMA_V
#undef WAIT_BAR
#undef NEXT3
#undef PREV3
#undef RESC
}
#undef MFMA8
#undef SBAR
}

constexpr int PER_PHASE = 9;
__global__ void __launch_bounds__(NWAVES * 64, 2) mk_fwd(Args args) {
    extern __shared__ __attribute__((aligned(16))) unsigned char lds_raw[];
    Frame F;
    F.lds = (LAS unsigned char*)lds_raw;
    volatile LAS unsigned* MISC = (volatile LAS unsigned*)(F.lds + MISC_OFF);
    F.wave = __builtin_amdgcn_readfirstlane(threadIdx.x >> 6);
    F.G = gridDim.x; { const int bx = blockIdx.x; F.vcu = (F.G % 8 == 0) ? (bx % 8) * (F.G / 8) + bx / 8 : bx; }
    unsigned char* ws0 = args.ws;
    gu32* ctl = (gu32*)(ws0 + WS_CTL);
    for (int u = threadIdx.x; u < (LDS_BYTES - LDSCTL_OFF) / 4; u += NWAVES * 64) ((LAS unsigned*)(F.lds + LDSCTL_OFF))[u] = 0u;
    __syncthreads();
    unsigned* const barw = (MK_SELFCLEAN && MK_N_LAUNCHES == 1) ? (unsigned*)g_xbar : (unsigned*)(ctl + CW_BAR);
    XcdBarrier bar; bar.bar = barw; bar.x = 0; bar.st = nullptr;
    if (MK_N_LAUNCHES == 1) bar = xcd_barrier_post(barw, MISC + 8);
    const int lo = args.ph_lo, hi = args.ph_hi;
#define PHASE_WS unsigned char* ws = ws0; asm volatile("" : "+s"(ws)); Args pa_ = args; pa_.ws = ws;
#define IN(k) (lo <= (k) && (k) < hi && ((MK_PHASE_MASK >> (k)) & 1))
#define REPS(k) for (int rep_ = 0; rep_ < 1 + ((MK_REPEAT_MASK >> (k)) & 1); ++rep_)
#define SEAM(k) do { if ((k) + 1 < hi) { if (MK_N_LAUNCHES == 1) xcd_barrier(bar); } } while (0)
    const int G = F.G, bx = (int)blockIdx.x;

    if (lo <= 0 && 0 < hi) { PHASE_WS REPS(0) if (IN(0)) p0_prologue(F, pa_); SEAM(0); if (MK_PROBE == 1) { for (int e = 0; e < 8; ++e) xcd_barrier(bar); } }
    if (lo <= 1 && 1 < hi) { PHASE_WS
        REPS(1) if (IN(1)) {
            const bool f8first = ((bx >> 3) & 1) != 0;
            if (!f8first) {
            { pg8::Gemm g{(const bf16*)(ws + WS_H), (const bf16*)(ws + WS_WIN), MTOK, P1_NT16 * 256, DM}; pg8::StaticOrder S; S.init(MTOK, P1_NT16 * 256, G, bx);
              EpiZ E{ws, 0, args.k_norm_g};
              pg8::gemm_phase<EpiZ, pg8::StaticOrder, true, true>(F.lds + RING_OFF, g, S, E, F.wave); }
            }
            { pg8::Gemm g{(const bf16*)(ws + WS_H8), (const bf16*)(ws + WS_WIN8), MTOK, P1_NT8 * 256, DM / 2}; pg8::StaticOrder S; S.init(MTOK, P1_NT8 * 256, G, bx);
              EpiZ E{ws, 1, args.k_norm_g};
              pg8::gemm_phase<EpiZ, pg8::StaticOrder, true, true, -1, 0>(F.lds + RING_OFF, g, S, E, F.wave); }
            if (f8first) {
            { pg8::Gemm g{(const bf16*)(ws + WS_H), (const bf16*)(ws + WS_WIN), MTOK, P1_NT16 * 256, DM}; pg8::StaticOrder S; S.init(MTOK, P1_NT16 * 256, G, bx);
              EpiZ E{ws, 0, args.k_norm_g};
              pg8::gemm_phase<EpiZ, pg8::StaticOrder, true, true>(F.lds + RING_OFF, g, S, E, F.wave); }
            }
            { const int nheavy = (MTOK / 256) * P1_NT8 % G;
              const int lane = lane_id_opaque();
              if (nheavy == 0) p0_items(pa_, (LAS float*)(F.lds + RING_OFF), F.wave, lane, bx, G, P0_EARLY, P0_NITEMS - P0_IN_P3);
              else if (bx >= nheavy) p0_items(pa_, (LAS float*)(F.lds + RING_OFF), F.wave, lane, bx - nheavy, G - nheavy, P0_EARLY, P0_NITEMS - P0_IN_P3); }
            __syncthreads(); }
        SEAM(1); }
    if (MK_LAT_FUSE >= 3 && MK_N_LAUNCHES == 1) {} else
    if (lo <= 2 && 2 < hi) { PHASE_WS REPS(2) if (IN(2)) p2_rowpass(F, pa_); SEAM(2); }
    for (int rp34 = 0; rp34 < (MK_PROBE == 2 ? 2 : 1); ++rp34) {
    if (lo <= 3 && 3 < hi) { PHASE_WS
        REPS(3) if (IN(3)) {
          {
            { pg8::Gemm g{(const bf16*)(ws + WS_QLAT), (const bf16*)(ws + WS_WUQ), MTOK, NH * DQK, QR / 2}; pg8::StaticOrder S; S.init(MTOK, NH * DQK, G, bx);
              if (MK_Q_FP8 && MK_ATT_FP8 == 5) { EpiF8 E{ws + WS_Q, NH * DQK, 8.0f, MK_LAT_FUSE ? (const float*)(ws + WS_SSQL) : nullptr};
              pg8::gemm_phase<EpiF8, pg8::StaticOrder, true, true, -1, 0>(F.lds + RING_OFF, g, S, E, F.wave); }
              else { EpiBf16 E{(bf16*)(ws + WS_Q), NH * DQK};
              pg8::gemm_phase<EpiBf16, pg8::StaticOrder, true, true, -1, 0>(F.lds + RING_OFF, g, S, E, F.wave); } }
            if (MK_LAT_FUSE >= 3 && MK_N_LAUNCHES == 1) p2_rowpass(F, pa_);
            { const int nfull = (MTOK / 256) * (NH * DQK / 256) % G;
              if (nfull != 0 && bx < nfull) { const int lane = lane_id_opaque(); p0_items(pa_, (LAS float*)(F.lds + RING_OFF), F.wave, lane, bx, nfull, P0_NITEMS - P0_IN_P3, P0_NITEMS); __syncthreads(); }
              if (nfull != 0 && bx >= nfull) { pg8::Gemm g2{(const bf16*)(ws + WS_PB), (const bf16*)(ws + WS_WPP), MTOK, DM, PLE}; pg8::StaticOrder S2; S2.init(MTOK, DM, G - nfull, bx - nfull);
                  EpiPP E2{ws};
                  pg8::gemm_phase<EpiPP, pg8::StaticOrder, true, true>(F.lds + RING_OFF, g2, S2, E2, F.wave); } }
            { pg8::Gemm g{(const bf16*)(ws + WS_KVLAT), (const bf16*)(ws + WS_WUKV), MTOK, NH * 256, KVR}; pg8::StaticOrder S; S.init(MTOK, NH * 256, G, bx);
              EpiKV E{(bf16*)(ws + WS_KF), (bf16*)(ws + WS_VT), (const float*)(ws + WS_RK), (const float*)(ws + WS_SSQKPE), args.k_norm_g, (LAS float*)(F.lds + EPI_RED_OFF), ws + WS_KF8_LO, ws + WS_KF8_HI, (const float*)(ws + WS_SSQL), 0};
              pg8::gemm_phase<EpiKV, pg8::StaticOrder, true, true>(F.lds + RING_OFF, g, S, E, F.wave); }
          }
        }
        SEAM(3); }
    }
    if (lo <= 5 && 5 < hi) { PHASE_WS
        REPS(5) if (IN(5)) {
            for (int U = F.vcu; U < BATCH * NH * 8; U += G) { const int bh = U >> 3, qb = U & 7;
                if (MK_ATT_FP8 == 5) att::attn_unit90(bh >> 4, bh & 15, qb, (const bf16*)(ws + WS_Q), ws + (((bh >> 4) < 2) ? WS_KF8_LO : WS_KF8_HI), ws + WS_VT, (const bf16*)(ws + WS_GA),
                                (bf16*)((unsigned char*)args.out + OUT_ACAT), args.q_norm_g, (const float*)(ws + WS_COS), (const float*)(ws + WS_SIN), F.lds + RING_OFF, F.wave);
                if (MK_ATT_FP8 == 4) att::attn_unit89(bh >> 4, bh & 15, qb, (const bf16*)(ws + WS_Q), ws + (((bh >> 4) < 2) ? WS_KF8_LO : WS_KF8_HI), ws + WS_VT, (const bf16*)(ws + WS_GA),
                                (bf16*)((unsigned char*)args.out + OUT_ACAT), args.q_norm_g, (const float*)(ws + WS_COS), (const float*)(ws + WS_SIN), F.lds + RING_OFF, F.wave);
                if (MK_ATT_FP8 == 3) att::attn_unit88(bh >> 4, bh & 15, qb, (const bf16*)(ws + WS_Q), ws + (((bh >> 4) < 2) ? WS_KF8_LO : WS_KF8_HI), ws + WS_VT, (const bf16*)(ws + WS_GA),
                                (bf16*)((unsigned char*)args.out + OUT_ACAT), args.q_norm_g, (const float*)(ws + WS_COS), (const float*)(ws + WS_SIN), F.lds + RING_OFF, F.wave);
                if (MK_ATT_FP8 == 0 || MK_ATT_FP8 == 2) att::attn_unit(bh >> 4, bh & 15, qb, (const bf16*)(ws + WS_Q), (const bf16*)(ws + WS_KF), (const bf16*)(ws + WS_VT), (const bf16*)(ws + WS_GA),
                                (bf16*)((unsigned char*)args.out + OUT_ACAT), args.q_norm_g, (const float*)(ws + WS_COS), (const float*)(ws + WS_SIN), F.lds + RING_OFF, F.wave);
                if (MK_ATT_FP8 == 1 || MK_ATT_FP8 == 2) att::attn_unit8<MK_ATT_FP8 == 2>(bh >> 4, bh & 15, qb, (const bf16*)(ws + WS_Q), ws + (((bh >> 4) < 2) ? WS_KF8_LO : WS_KF8_HI), (const bf16*)(ws + WS_VT), (const bf16*)(ws + WS_GA),
                                (bf16*)((unsigned char*)args.out + OUT_ACAT), args.q_norm_g, (const float*)(ws + WS_COS), (const float*)(ws + WS_SIN), F.lds + RING_OFF, F.wave, (float*)(ws + WS_CTL) + CW_CHK); }
        }
        SEAM(5); }
    if (lo <= 6 && 6 < hi) { PHASE_WS
        REPS(6) if (IN(6)) {
            { pg8::Gemm g{(const bf16*)((unsigned char*)args.out + OUT_ACAT), (const bf16*)(ws + WS_WCAT), MTOK, DM, ACAT_LD}; pg8::StaticOrder S; S.init(MTOK, DM, G, bx);
              EpiMerge2 E{(const bf16*)(ws + WS_MAMC), (bf16*)(ws + WS_MERGED)};
              pg8::gemm_phase<EpiMerge2, pg8::StaticOrder, true, true, CW / 64, MK_BA_FP8 ? CW / 64 : (1 << 30), 0x7B7B7B7B>(F.lds + RING_OFF, g, S, E, F.wave); }
        }
        SEAM(6); }
    for (int rp78 = 0; rp78 < (MK_PROBE == 3 ? 2 : 1); ++rp78) {
    if (lo <= 7 && 7 < hi) { PHASE_WS
        REPS(7) if (IN(7)) { pg8::Gemm g{(const bf16*)(ws + WS_MERGED), (const bf16*)(ws + WS_WOUT), MTOK, DM, DM}; pg8::StaticOrder S; S.init(MTOK, DM, G, bx);
            EpiX1 E{args.x, (float*)(ws + WS_X1F), (bf16*)(ws + WS_X1G), (float*)(ws + WS_SSQ1P)};
            pg8::gemm_phase<EpiX1, pg8::StaticOrder, true, true>(F.lds + RING_OFF, g, S, E, F.wave);
 }
        SEAM(7); }
    if (lo <= 8 && 8 < hi) { PHASE_WS
        REPS(8) if (IN(8)) {
            if ((MTOK / 256) * (NH * DQK / 256) % G == 0) { pg8::Gemm g{(const bf16*)(ws + WS_PB), (const bf16*)(ws + WS_WPP), MTOK, DM, PLE}; pg8::StaticOrder S; S.init(MTOK, DM, G, bx);
              EpiBf16 E{(bf16*)(ws + WS_PPROJ), DM};
              pg8::gemm_phase<EpiBf16, pg8::StaticOrder, true, true>(F.lds + RING_OFF, g, S, E, F.wave);
              VM_WAIT(); __syncthreads(); }
            { pg8::Gemm g{(const bf16*)(ws + WS_X1G), (const bf16*)(ws + WS_WPG), MTOK, DM, DM}; pg8::StaticOrder S; S.init(MTOK, DM, G, bx);
              EpiOut E{(const float*)(ws + WS_X1F), args.out, (const bf16*)(ws + (MK_PP_SPLIT ? 0 : WS_PPROJ)), (const float*)(ws + WS_SSQ1P), (const bf16*)(ws + WS_X1G)};
              pg8::gemm_phase<EpiOut, pg8::StaticOrder, true, true>(F.lds + RING_OFF, g, S, E, F.wave); }
        }
    }
    if (MK_PROBE == 3 && rp78 == 0) xcd_barrier(bar);
    }
    if (MK_ATT_FP8 == 2 && MK_N_LAUNCHES == 1) {
        xcd_barrier(bar);
        const float dsum = ((const float*)(ws0 + WS_CTL))[CW_CHK], rsum = ((const float*)(ws0 + WS_CTL))[CW_CHK + 1];
        if (!(dsum <= 0.04f * rsum) || !(rsum > 0.f)) { const float qn = __builtin_nanf(""); for (int i = bx * 512 + F.wave * 64 + lane_id_opaque(); i < MTOK * DM; i += G * 512) args.out[i] = qn; }
    }
    if (MK_SELFCLEAN && MK_N_LAUNCHES == 1) {
        if (threadIdx.x == 0) {
            const unsigned old = xb_add(&barw[XB_DONE], 1u);
            if (old + 1u == (unsigned)G) {
#pragma unroll
                for (unsigned j = 0; j < 16; ++j) { __hip_atomic_store(&barw[XB_XCNT(j)], 0u, RLX_AGENT); __hip_atomic_store(&barw[XB_XSUB(j)], 0u, RLX_AGENT); __hip_atomic_store(&barw[XB_XGEN(j)], 0u, RLX_AGENT); }
                __hip_atomic_store(&barw[XB_TOP], 0u, RLX_AGENT); __hip_atomic_store(&barw[XB_TOPGEN], 0u, RLX_AGENT); __hip_atomic_store(&barw[XB_DONE], 0u, RLX_AGENT);
            }
        }
    }
#undef PHASE_WS
#undef IN
#undef SEAM
}

extern "C" void kernel_launch(void* const* d_in, const int* in_sizes, int n_in, void* d_out, int out_size, void* d_ws, size_t ws_size, hipStream_t stream) {
    static int grid = 0;
    if (grid == 0) {
        if (n_in != 19 || in_sizes[0] != MTOK * DM || out_size != MTOK * DM || ws_size < WS_END) {
            fprintf(stderr, "kernel_launch: shape/workspace mismatch: n_in %d in0 %d out %d ws %zu (need >= %zu); nothing launched\n", n_in, n_in > 0 ? in_sizes[0] : -1, out_size, ws_size, (size_t)WS_END); grid = -1; return; }
        int dev = 0, cus = 0, per_cu = 0;
        if (hipGetDevice(&dev) != hipSuccess || hipDeviceGetAttribute(&cus, hipDeviceAttributeMultiprocessorCount, dev) != hipSuccess) { fprintf(stderr, "kernel_launch: device query failed\n"); grid = -1; return; }
        if (hipFuncSetAttribute((const void*)mk_fwd, hipFuncAttributeMaxDynamicSharedMemorySize, LDS_BYTES) != hipSuccess) { fprintf(stderr, "kernel_launch: hipFuncSetAttribute failed\n"); grid = -1; return; }
        if (hipOccupancyMaxActiveBlocksPerMultiprocessor(&per_cu, (const void*)mk_fwd, NWAVES * 64, LDS_BYTES) != hipSuccess || per_cu < 1) {
            fprintf(stderr, "kernel_launch: occupancy query reports %d workgroups per CU\n", per_cu); (void)hipGetLastError(); grid = -1; return; }
        grid = cus;
    }
    if (grid < 0) return;
    if (!(MK_SELFCLEAN && MK_N_LAUNCHES == 1)) (void)hipMemsetAsync((char*)d_ws + WS_CTL, 0, CTL_ZERO_BYTES, stream);
    Args a{};
    a.x = (const float*)d_in[0]; a.p = (const float*)d_in[1]; a.positions = (const int*)d_in[2]; a.norm_g = (const float*)d_in[3]; a.w_in = (const float*)d_in[4];
    a.q_lat_g = (const float*)d_in[5]; a.kv_lat_g = (const float*)d_in[6]; a.w_uq = (const float*)d_in[7]; a.w_ukv = (const float*)d_in[8]; a.q_norm_g = (const float*)d_in[9];
    a.k_norm_g = (const float*)d_in[10]; a.conv_w = (const float*)d_in[11]; a.conv_b = (const float*)d_in[12]; a.w_ba = (const float*)d_in[13]; a.w_bc = (const float*)d_in[14];
    a.w_out = (const float*)d_in[15]; a.ple_norm_g = (const float*)d_in[16]; a.w_pg = (const float*)d_in[17]; a.w_pp = (const float*)d_in[18];
    a.out = (float*)d_out; a.ws = (unsigned char*)d_ws;
    if (MK_N_LAUNCHES == 1) {
        a.ph_lo = 0; a.ph_hi = PER_PHASE;
        void* kargs[] = {(void*)&a};
        const hipError_t ce = hipLaunchCooperativeKernel((const void*)mk_fwd, dim3(grid), dim3(NWAVES * 64), kargs, LDS_BYTES, stream);
        if (ce != hipSuccess) fprintf(stderr, "kernel_launch: cooperative launch failed: %s (grid %d)\n", hipGetErrorName(ce), grid);
    } else {
        for (int li = 0; li < PER_PHASE; ++li) { a.ph_lo = li; a.ph_hi = li + 1; hipLaunchKernelGGL(mk_fwd, dim3(grid), dim3(NWAVES * 64), LDS_BYTES, stream, a); }
    }
    const hipError_t le = hipPeekAtLastError();
    if (le != hipSuccess) fprintf(stderr, "kernel_launch: launch failed: %s\n", hipGetErrorName(le));
}
```
